# Optimizing an MI355X kernel written in HIP

```python
import jax, jax.numpy as jnp
from jax import lax
import numpy as np


D_MODEL = 1024
BATCH = 4
SEQ = 8192
DEPTH = 2

PLE_DIM = 256
D_FF = 2816
EPS = 1e-6
MLA_HEADS = 8
MLA_NOPE = 64
MLA_ROPE = 32
MLA_V = 64
MLA_Q_RANK = 384
MLA_KV_RANK = 256
ROPE_BASE = 10000.0
Q_BLOCK = 128
GLA_HEADS = 4
GLA_DK = 64
GLA_DV = 128
GLA_GATE_RANK = 16
GLA_TAU = 16.0
GLA_CHUNK = 64
RG_WIDTH = 512
RG_BLOCKS = 8
RG_CONV = 4
RG_C = 8.0
S5_GROUP = 16
S5_GROUPS = 32
S5_STATE = 64
S5_WIDTH = S5_GROUP * S5_GROUPS

EVEN_MIX_WIDTH = MLA_HEADS * MLA_V + GLA_HEADS * GLA_DV
ODD_MIX_WIDTH = RG_WIDTH + S5_WIDTH
EVEN_IN_SPLITS = [MLA_Q_RANK, MLA_KV_RANK, MLA_ROPE,
                  GLA_HEADS * GLA_DK, GLA_HEADS * GLA_DK, GLA_HEADS * GLA_DV,
                  GLA_GATE_RANK, GLA_HEADS * GLA_DV]
EVEN_IN_WIDTH = sum(EVEN_IN_SPLITS)
ODD_IN_SPLITS = [RG_WIDTH, RG_WIDTH, S5_WIDTH]
ODD_IN_WIDTH = sum(ODD_IN_SPLITS)
N_EVEN = (DEPTH + 1) // 2
N_ODD = DEPTH // 2

kernel_name = 'hybrid_mla_gla_rglru_s5_macaron'


def rms_norm(x, g):
    x32 = x.astype(jnp.float32)
    y = x32 * lax.rsqrt(jnp.mean(x32 * x32, axis=-1, keepdims=True) + EPS)
    return y.astype(x.dtype) * g


def split_cols(y, sizes):
    offs = [sum(sizes[:n]) for n in range(1, len(sizes))]
    return jnp.split(y, offs, axis=-1)


def swiglu(x, w1, w3, w2):
    return (jax.nn.silu(x @ w1) * (x @ w3)) @ w2


def rope(x, positions):
    half = MLA_ROPE // 2
    inv = ROPE_BASE ** (-jnp.arange(half, dtype=jnp.float32) / half)
    ang = positions.astype(jnp.float32)[:, None] * inv[None, :]
    cos = jnp.cos(ang)[:, None, :]
    sin = jnp.sin(ang)[:, None, :]
    x1, x2 = x[..., :half], x[..., half:]
    return jnp.concatenate([x1 * cos - x2 * sin, x1 * sin + x2 * cos], axis=-1).astype(x.dtype)


def mla(c_q, c_kv, k_rope_in, q_norm, w_q_up, kv_norm, w_kv_up):
    B, S, _ = c_q.shape
    pos = jnp.arange(S)
    q = (rms_norm(c_q, q_norm) @ w_q_up).reshape(B, S, MLA_HEADS, MLA_NOPE + MLA_ROPE)
    scale = (MLA_NOPE + MLA_ROPE) ** -0.5
    q_nope = q[..., :MLA_NOPE] * scale
    q_rope = rope(q[..., MLA_NOPE:], pos) * scale
    kv = (rms_norm(c_kv, kv_norm) @ w_kv_up).reshape(B, S, MLA_HEADS, MLA_NOPE + MLA_V)
    k_nope, v = kv[..., :MLA_NOPE], kv[..., MLA_NOPE:]
    k_rope = rope(k_rope_in[:, :, None, :], pos)[:, :, 0, :]
    outs = []
    for blk in range(S // Q_BLOCK):
        s0 = blk * Q_BLOCK
        s1 = s0 + Q_BLOCK
        sc = (jnp.einsum('bqhd,bkhd->bhqk', q_nope[:, s0:s1], k_nope[:, :s1])
              + jnp.einsum('bqhr,bkr->bhqk', q_rope[:, s0:s1], k_rope[:, :s1]))
        mask = jnp.arange(s1)[None, :] <= jnp.arange(s0, s1)[:, None]
        sc = jnp.where(mask, sc.astype(jnp.float32), -jnp.inf)
        pr = jax.nn.softmax(sc, axis=-1).astype(v.dtype)
        outs.append(jnp.einsum('bhqk,bkhd->bqhd', pr, v[:, :s1]))
    o = jnp.concatenate(outs, axis=1)
    return o.reshape(B, S, MLA_HEADS * MLA_V)


def gla(q, k, v, g_low, r, w_gate_up, b_gate, out_norm):
    B, S, _ = q.shape
    H, dk, dv, C = GLA_HEADS, GLA_DK, GLA_DV, GLA_CHUNK
    N = S // C
    f32 = jnp.float32

    def heads(t, d):
        return t.astype(f32).reshape(B, N, C, H, d).transpose(0, 3, 1, 2, 4)

    qh = heads(q, dk) * (dk ** -0.5)
    kh = heads(k, dk)
    vh = heads(v, dv)
    g = jax.nn.log_sigmoid((g_low @ w_gate_up + b_gate).astype(f32)) / GLA_TAU
    b = jnp.cumsum(heads(g, dk), axis=3)
    b_last = b[:, :, :, -1:, :]
    q_e = qh * jnp.exp(b)
    k_e = kh * jnp.exp(-b)
    causal = jnp.tril(jnp.ones((C, C), dtype=bool))
    att = jnp.where(causal, jnp.einsum('bhncd,bhnjd->bhncj', q_e, k_e), 0.0)
    o_intra = jnp.einsum('bhncj,bhnje->bhnce', att, vh)
    k_end = kh * jnp.exp(b_last - b)
    chunk_kv = jnp.einsum('bhncd,bhnce->nbhde', k_end, vh)
    decay = jnp.exp(b_last[:, :, :, 0, :]).transpose(2, 0, 1, 3)

    def step(state, inp):
        dec, kv = inp
        return dec[..., None] * state + kv, state

    _, states = lax.scan(step, jnp.zeros((B, H, dk, dv), f32), (decay, chunk_kv))
    o_inter = jnp.einsum('bhncd,nbhde->bhnce', q_e, states)
    o = (o_intra + o_inter).transpose(0, 2, 3, 1, 4).reshape(B, S, H, dv)
    o = rms_norm(o, out_norm).reshape(B, S, H * dv) * jax.nn.silu(r.astype(f32))
    return o.astype(q.dtype)


def even_mixer(xn, w_in, q_norm, w_q_up, kv_norm, w_kv_up, w_gate_up, b_gate, out_norm, w_out):
    c_q, c_kv, k_r, gq, gk, gv, g_low, g_r = split_cols(xn @ w_in, EVEN_IN_SPLITS)
    y_a = mla(c_q, c_kv, k_r, q_norm, w_q_up, kv_norm, w_kv_up)
    y_b = gla(gq, gk, gv, g_low, g_r, w_gate_up, b_gate, out_norm)
    return jnp.concatenate([y_a, y_b], axis=-1) @ w_out


def rg_lru_branch(x_gate, x_in, conv_w, conv_b, w_a, b_a, w_i, b_i, lam):
    B, S, W = x_in.shape
    f32 = jnp.float32
    xc = lax.conv_general_dilated(x_in, conv_w[:, None, :], window_strides=(1,),
                                  padding=[(RG_CONV - 1, 0)],
                                  dimension_numbers=('NWC', 'WIO', 'NWC'),
                                  feature_group_count=W) + conv_b
    xb = xc.reshape(B, S, RG_BLOCKS, W // RG_BLOCKS)
    r = jax.nn.sigmoid(jnp.einsum('bshi,hij->bshj', xb, w_a).reshape(B, S, W) + b_a)
    i = jax.nn.sigmoid(jnp.einsum('bshi,hij->bshj', xb, w_i).reshape(B, S, W) + b_i)
    log_a = (-RG_C * jax.nn.softplus(-lam) * r).astype(f32)
    a = jnp.exp(log_a)
    bx = jnp.sqrt(-jnp.expm1(2.0 * log_a)) * (i * xc).astype(f32)

    def comb(e1, e2):
        a1, b1 = e1
        a2, b2 = e2
        return a1 * a2, a2 * b1 + b2

    _, h = lax.associative_scan(comb, (a, bx), axis=1)
    return h.astype(x_in.dtype) * jax.nn.gelu(x_gate)


def s5_branch(u, a_re, a_im, log_dt, b_re, b_im, c_re, c_im, d, w_glu, b_glu):
    B, S, _ = u.shape
    f32 = jnp.float32
    ug = u.astype(f32).reshape(B, S, S5_GROUPS, S5_GROUP)
    dt = jnp.exp(log_dt.astype(f32))[:, None]
    lr, li = a_re.astype(f32), a_im.astype(f32)
    mag = jnp.exp(lr * dt)
    ab_re = mag * jnp.cos(li * dt)
    ab_im = mag * jnp.sin(li * dt)
    den = lr * lr + li * li
    nr, ni = ab_re - 1.0, ab_im
    coef_re = (nr * lr + ni * li) / den
    coef_im = (ni * lr - nr * li) / den
    bb_re = coef_re[..., None] * b_re - coef_im[..., None] * b_im
    bb_im = coef_re[..., None] * b_im + coef_im[..., None] * b_re
    bu_re = jnp.einsum('bsgc,gpc->bsgp', ug, bb_re)
    bu_im = jnp.einsum('bsgc,gpc->bsgp', ug, bb_im)
    at_re = jnp.broadcast_to(ab_re, (1, S) + ab_re.shape)
    at_im = jnp.broadcast_to(ab_im, (1, S) + ab_im.shape)

    def comb(e1, e2):
        a1r, a1i, b1r, b1i = e1
        a2r, a2i, b2r, b2i = e2
        return (a2r * a1r - a2i * a1i, a2r * a1i + a2i * a1r,
                a2r * b1r - a2i * b1i + b2r, a2r * b1i + a2i * b1r + b2i)

    _, _, x_re, x_im = lax.associative_scan(comb, (at_re, at_im, bu_re, bu_im), axis=1)
    y = (jnp.einsum('bsgp,gcp->bsgc', x_re, c_re) - jnp.einsum('bsgp,gcp->bsgc', x_im, c_im)
         + d * ug)
    y = jax.nn.gelu(y.reshape(B, S, S5_WIDTH))
    y = y * jax.nn.sigmoid(y @ w_glu + b_glu)
    return y.astype(u.dtype)


def odd_mixer(xn, w_in, conv_w, conv_b, w_a, b_a, w_i, b_i, lam,
              a_re, a_im, log_dt, b_re, b_im, c_re, c_im, d, w_glu, b_glu, w_out):
    x_gate, x_rg, u = split_cols(xn @ w_in, ODD_IN_SPLITS)
    y_c = rg_lru_branch(x_gate, x_rg, conv_w, conv_b, w_a, b_a, w_i, b_i, lam)
    y_d = s5_branch(u, a_re, a_im, log_dt, b_re, b_im, c_re, c_im, d, w_glu, b_glu)
    return jnp.concatenate([y_c, y_d], axis=-1) @ w_out


def setup_inputs(seed: int = 0) -> dict:
    key = jax.random.key(seed)
    ks = iter(jax.random.split(key, 64))
    f32 = jnp.float32
    D, L, NE, NO = D_MODEL, DEPTH, N_EVEN, N_ODD
    G, P = S5_GROUPS, S5_STATE

    def nrm(shape, fan_in):
        return jax.random.normal(next(ks), shape, f32) * (fan_in ** -0.5)

    def gain(shape):
        return 1.0 + 0.01 * jax.random.normal(next(ks), shape, f32)

    def small(shape):
        return 0.01 * jax.random.normal(next(ks), shape, f32)

    x = jax.random.normal(next(ks), (BATCH, SEQ, D), f32)
    p = jax.random.normal(next(ks), (DEPTH, BATCH, SEQ, PLE_DIM), f32)
    u_lam = jax.random.uniform(next(ks), (NO, RG_WIDTH), f32, 0.9, 0.999)
    a_lam = u_lam ** (1.0 / RG_C)
    rg_lambda = jnp.log(a_lam) - jnp.log1p(-a_lam)
    s5_a_re = -0.5 + small((NO, G, P))
    s5_a_im = jnp.pi * jnp.arange(P, dtype=f32) + small((NO, G, P))
    s5_log_dt = jnp.log(jax.random.uniform(next(ks), (NO, G), f32, 0.001, 0.1))
    return {
        'x': x, 'p': p,
        'ffn_a_norm': gain((L, D)), 'ffn_a_w1': nrm((L, D, D_FF), D),
        'ffn_a_w3': nrm((L, D, D_FF), D), 'ffn_a_w2': nrm((L, D_FF, D), D_FF),
        'mix_norm': gain((L, D)),
        'ffn_b_norm': gain((L, D)), 'ffn_b_w1': nrm((L, D, D_FF), D),
        'ffn_b_w3': nrm((L, D, D_FF), D), 'ffn_b_w2': nrm((L, D_FF, D), D_FF),
        'ple_norm': gain((L, D)), 'ple_w_gate': nrm((L, D, D), D),
        'ple_w_up': nrm((L, PLE_DIM, D), PLE_DIM),
        'ev_w_in': nrm((NE, D, EVEN_IN_WIDTH), D),
        'mla_q_norm': gain((NE, MLA_Q_RANK)),
        'mla_w_q_up': nrm((NE, MLA_Q_RANK, MLA_HEADS * (MLA_NOPE + MLA_ROPE)), MLA_Q_RANK),
        'mla_kv_norm': gain((NE, MLA_KV_RANK)),
        'mla_w_kv_up': nrm((NE, MLA_KV_RANK, MLA_HEADS * (MLA_NOPE + MLA_V)), MLA_KV_RANK),
        'gla_w_gate_up': nrm((NE, GLA_GATE_RANK, GLA_HEADS * GLA_DK), GLA_GATE_RANK),
        'gla_b_gate': small((NE, GLA_HEADS * GLA_DK)),
        'gla_out_norm': gain((NE, GLA_DV)),
        'ev_w_out': nrm((NE, EVEN_MIX_WIDTH, D), EVEN_MIX_WIDTH),
        'od_w_in': nrm((NO, D, ODD_IN_WIDTH), D),
        'rg_conv_w': nrm((NO, RG_CONV, RG_WIDTH), RG_CONV),
        'rg_conv_b': small((NO, RG_WIDTH)),
        'rg_w_a': nrm((NO, RG_BLOCKS, RG_WIDTH // RG_BLOCKS, RG_WIDTH // RG_BLOCKS), RG_WIDTH // RG_BLOCKS),
        'rg_b_a': small((NO, RG_WIDTH)),
        'rg_w_i': nrm((NO, RG_BLOCKS, RG_WIDTH // RG_BLOCKS, RG_WIDTH // RG_BLOCKS), RG_WIDTH // RG_BLOCKS),
        'rg_b_i': small((NO, RG_WIDTH)),
        'rg_lambda': rg_lambda,
        's5_a_re': s5_a_re, 's5_a_im': s5_a_im, 's5_log_dt': s5_log_dt,
        's5_b_re': nrm((NO, G, P, S5_GROUP), 2 * S5_GROUP),
        's5_b_im': nrm((NO, G, P, S5_GROUP), 2 * S5_GROUP),
        's5_c_re': nrm((NO, G, S5_GROUP, P), P),
        's5_c_im': nrm((NO, G, S5_GROUP, P), P),
        's5_d': jax.random.normal(next(ks), (NO, G, S5_GROUP), f32),
        's5_w_glu': nrm((NO, S5_WIDTH, S5_WIDTH), S5_WIDTH),
        's5_b_glu': small((NO, S5_WIDTH)),
        'od_w_out': nrm((NO, ODD_MIX_WIDTH, D), ODD_MIX_WIDTH),
        'final_norm': gain((D,)),
    }


def reference(x, p, ffn_a_norm, ffn_a_w1, ffn_a_w3, ffn_a_w2, mix_norm,
              ffn_b_norm, ffn_b_w1, ffn_b_w3, ffn_b_w2, ple_norm, ple_w_gate, ple_w_up,
              ev_w_in, mla_q_norm, mla_w_q_up, mla_kv_norm, mla_w_kv_up,
              gla_w_gate_up, gla_b_gate, gla_out_norm, ev_w_out,
              od_w_in, rg_conv_w, rg_conv_b, rg_w_a, rg_b_a, rg_w_i, rg_b_i, rg_lambda,
              s5_a_re, s5_a_im, s5_log_dt, s5_b_re, s5_b_im, s5_c_re, s5_c_im, s5_d,
              s5_w_glu, s5_b_glu, od_w_out, final_norm):
    h = x
    for i in range(DEPTH):
        h = h + 0.5 * swiglu(rms_norm(h, ffn_a_norm[i]), ffn_a_w1[i], ffn_a_w3[i], ffn_a_w2[i])
        hn = rms_norm(h, mix_norm[i])
        j = i // 2
        if i % 2 == 0:
            h = h + even_mixer(hn, ev_w_in[j], mla_q_norm[j], mla_w_q_up[j], mla_kv_norm[j],
                               mla_w_kv_up[j], gla_w_gate_up[j], gla_b_gate[j],
                               gla_out_norm[j], ev_w_out[j])
        else:
            h = h + odd_mixer(hn, od_w_in[j], rg_conv_w[j], rg_conv_b[j], rg_w_a[j], rg_b_a[j],
                              rg_w_i[j], rg_b_i[j], rg_lambda[j], s5_a_re[j], s5_a_im[j],
                              s5_log_dt[j], s5_b_re[j], s5_b_im[j], s5_c_re[j], s5_c_im[j],
                              s5_d[j], s5_w_glu[j], s5_b_glu[j], od_w_out[j])
        h = h + 0.5 * swiglu(rms_norm(h, ffn_b_norm[i]), ffn_b_w1[i], ffn_b_w3[i], ffn_b_w2[i])
        h = h + (p[i] @ ple_w_up[i]) * jax.nn.sigmoid(rms_norm(h, ple_norm[i]) @ ple_w_gate[i])
    return rms_norm(h, final_norm)
```

```cpp
#include <hip/hip_runtime.h>
#include <hip/hip_cooperative_groups.h>
#include <cstdio>
#include <cstdint>
namespace cg = cooperative_groups;

#ifndef REPEAT_MASK
#define REPEAT_MASK 0u
#endif
#ifndef MK_PER_PHASE_LAUNCH
#define MK_PER_PHASE_LAUNCH 0
#endif

#define LAS __attribute__((address_space(3)))
typedef unsigned short bf16_t;
typedef unsigned char uchar;
typedef short bf16x8 __attribute__((ext_vector_type(8)));
typedef short s16x4 __attribute__((ext_vector_type(4)));
typedef float f32x4 __attribute__((ext_vector_type(4)));
typedef float f32x16 __attribute__((ext_vector_type(16)));
typedef unsigned u32x4 __attribute__((ext_vector_type(4)));
typedef unsigned u32x2 __attribute__((ext_vector_type(2)));
typedef float f32x2_t __attribute__((ext_vector_type(2)));
typedef __bf16 bf16x2_t __attribute__((ext_vector_type(2)));

constexpr int T = 32768, SEQ = 8192, DM = 1024, FF = 2816;
constexpr float EPS = 1e-6f;
constexpr int NPHASE = 23;
constexpr int NTHR = 512;

constexpr size_t MiB = 1u << 20;
constexpr size_t WS_STAT = 0;
constexpr size_t STAT_ZERO_BYTES = 3 * MiB;
constexpr size_t WS_XBAR = 3 * MiB - 64 * 1024;
constexpr size_t WS_ROPE = 4 * MiB;
constexpr size_t WS_AL = 5 * MiB;
constexpr size_t WS_C8SP = 5 * MiB + 64 * 1024;
constexpr size_t WS_DECAY = 6 * MiB;
constexpr size_t WS_APROD = 7 * MiB;
constexpr size_t WS_HEND = 8 * MiB;
constexpr size_t WS_W = 10 * MiB;
constexpr size_t W13_B = (size_t)5632 * 1024 * 2, W2_B = (size_t)1024 * 2816 * 2;
constexpr size_t WO_W13 = 0;
constexpr size_t WO_W2 = WO_W13 + 4 * W13_B;
constexpr size_t WO_WG = WO_W2 + 4 * W2_B;
constexpr size_t WO_WUP = WO_WG + 2 * (size_t)1024 * 1024 * 2;
constexpr size_t WO_WINE = WO_WUP + 2 * (size_t)1024 * 256 * 2;
constexpr size_t WO_WQ = WO_WINE + (size_t)2304 * 1024 * 2;
constexpr size_t WO_WKV = WO_WQ + (size_t)768 * 384 * 2;
constexpr size_t WO_WOUTE = WO_WKV + (size_t)1024 * 256 * 2;
constexpr size_t WO_WINO = WO_WOUTE + (size_t)1024 * 1024 * 2;
constexpr size_t WO_WRG = WO_WINO + (size_t)1536 * 1024 * 2;
constexpr size_t WO_WGLU = WO_WRG + (size_t)1024 * 512 * 2;
constexpr size_t WO_WOUTO = WO_WGLU + (size_t)512 * 512 * 2;
constexpr size_t WO_MW = WO_WOUTO + (size_t)1024 * 1024 * 2;
constexpr size_t WO_WZ = WO_MW + (size_t)32 * 512 * 640 * 2;
constexpr size_t WO_END = WO_WZ + (size_t)32 * 256 * 512 * 2;
static_assert(WS_W + WO_END <= 124 * MiB, "weights region");
constexpr size_t WS_HBA = 124 * MiB;
constexpr size_t WS_HBB = 188 * MiB;
constexpr size_t WS_PB = 252 * MiB;
constexpr size_t WS_R = 284 * MiB;
constexpr size_t WS_G = WS_R;
constexpr size_t WS_U = WS_R;
constexpr size_t WS_Y = WS_R;
constexpr size_t WS_Q = WS_R + 144 * MiB;
constexpr size_t WS_KR = WS_R + 192 * MiB;
constexpr size_t WS_CKV = WS_R + 194 * MiB;
constexpr size_t WS_YO = WS_R;
constexpr size_t WS_UPK = WS_R + 64 * MiB;
constexpr size_t WS_XC = WS_R + 104 * MiB;
constexpr size_t WS_Z = WS_R + 136 * MiB;
constexpr size_t WS_YG = WS_R + 152 * MiB;
constexpr size_t WS_END = 512 * MiB;
static_assert(WS_CKV + 32 * MiB <= WS_END && WS_YG + 32 * MiB <= WS_END, "ws map");

constexpr int XB_LDS_OFF = 131072 + 2048;
constexpr int LDS_BYTES = 135168;

constexpr int YC_GQ = 640, YC_GK = 896, YC_GV = 1152, YC_GR = 1664, YC_KR = 2176, YC_GLOW = 2208, YLD = 2304;

struct Args { const float* in[43]; float* out; uchar* ws; int ph_lo, ph_hi; };
typedef const __attribute__((address_space(4))) uchar* kaptr_t;
__device__ __forceinline__ kaptr_t ka_base() { kaptr_t p = (kaptr_t)__builtin_amdgcn_kernarg_segment_ptr(); asm volatile("" : "+s"(p)); return p; }
#define IN_(i) (*(const float* const __attribute__((address_space(4)))*)(ka_base() + 8 * (i)))

__device__ __forceinline__ unsigned pk2(float lo, float hi) { f32x2_t v = {lo, hi}; bf16x2_t b = __builtin_convertvector(v, bf16x2_t); return __builtin_bit_cast(unsigned, b); }
__device__ __forceinline__ float bf_lo(unsigned w) { return __uint_as_float(w << 16); }
__device__ __forceinline__ float bf_hi(unsigned w) { return __uint_as_float(w & 0xffff0000u); }
__device__ __forceinline__ float bf1(bf16_t v) { return __uint_as_float(((unsigned)v) << 16); }
__device__ __forceinline__ bf16_t f2bf1(float f) { return (bf16_t)(pk2(f, 0.f) & 0xffffu); }
__device__ __forceinline__ u32x4 pack8(f32x4 a, f32x4 b) { return (u32x4){pk2(a[0], a[1]), pk2(a[2], a[3]), pk2(b[0], b[1]), pk2(b[2], b[3])}; }
__device__ __forceinline__ void unpack8(u32x4 w, f32x4& a, f32x4& b) { a = (f32x4){bf_lo(w[0]), bf_hi(w[0]), bf_lo(w[1]), bf_hi(w[1])}; b = (f32x4){bf_lo(w[2]), bf_hi(w[2]), bf_lo(w[3]), bf_hi(w[3])}; }
__device__ __forceinline__ float fexp(float x) { return __builtin_amdgcn_exp2f(x * 1.4426950408889634f); }
__device__ __forceinline__ float sigmoidf_(float x) { return __builtin_amdgcn_rcpf(1.f + __builtin_amdgcn_exp2f(x * -1.4426950408889634f)); }
__device__ __forceinline__ float one_minus_exp(float x) {
  const float ser = -x * (1.f + x * (0.5f + x * (1.f / 6.f + x * (1.f / 24.f))));
  return x > -0.05f ? ser : 1.f - fexp(x);
}
__device__ __forceinline__ float siluf_(float x) { return x * sigmoidf_(x); }
__device__ __forceinline__ float geluf_(float x) { return x * sigmoidf_(1.5957691216057308f * (x + 0.044715f * x * x * x)); }
typedef unsigned long long sq_t;
__device__ __forceinline__ float rs_of(sq_t sumsq, float inv_n) { return __builtin_amdgcn_rsqf((float)sumsq * (1.f / 16777216.f) * inv_n + EPS); }
__device__ __forceinline__ void sq_add(sq_t* p, float part) { atomicAdd(p, (sq_t)(part * 16777216.f + 0.5f)); }
__device__ __forceinline__ float shx(float v, int m) { return __shfl_xor(v, m, 64); }
__device__ __forceinline__ void sincos_acc(double x, double& s, double& c) {
  const double k = rint(x * 0.63661977236758134308);
  const double r = fma(-k, 1.57079632679489655800, x) - k * 6.12323399573676603587e-17;
  const double r2 = r * r;
  double sp = r * (1.0 + r2 * (-1.0 / 6 + r2 * (1.0 / 120 + r2 * (-1.0 / 5040 + r2 * (1.0 / 362880 + r2 * (-1.0 / 39916800 + r2 * (1.0 / 6227020800.0)))))));
  double cp = 1.0 + r2 * (-0.5 + r2 * (1.0 / 24 + r2 * (-1.0 / 720 + r2 * (1.0 / 40320 + r2 * (-1.0 / 3628800 + r2 * (1.0 / 479001600.0 + r2 * (-1.0 / 87178291200.0)))))));
  const int q = ((int)(long long)k) & 3;
  if (q == 0) { s = sp; c = cp; } else if (q == 1) { s = cp; c = -sp; } else if (q == 2) { s = -sp; c = -cp; } else { s = -cp; c = sp; }
}

namespace pg8 {
constexpr int BM = 256, BK = 64, HALF = 128, HTB = HALF * BK * 2, STAGE_BYTES = 8 * HTB, NXCD = 8, WGM = 8;
__host__ __device__ __forceinline__ int lds_byte(int r, int c) { const int st = (r >> 4) * 2 + (c >> 5), rr = r & 15, cc = c & 31, ob = rr * 64 + cc * 2; return st * 1024 + (ob ^ (((ob >> 9) & 1) << 5)); }
__host__ __device__ __forceinline__ void stage_rc(int b, int& R, int& C) { const int st = b / 1024, sb = b % 1024, swz = sb ^ (((sb >> 9) & 1) << 5); R = (st >> 1) * 16 + swz / 64; C = (st & 1) * 32 + (swz % 64) / 2; }
__host__ __device__ __forceinline__ int perm32(int rho) { const int n = rho >> 4, i = rho & 15; return 8 * (i >> 2) + 4 * n + (i & 3); }

struct Unit { int pm, pn, z; };
struct Gemm { const bf16_t* A; const bf16_t* Bt; };
template <int M_, int N_, int NZ_> struct Order {
  static constexpr int nM = M_ / BM, nN = N_ / BM, per = nM * nN, nz = NZ_, nwg = per * NZ_;
  int G, c;
  __device__ __forceinline__ void init(int G_, int c_) { G = G_; c = c_; }
  __device__ __forceinline__ bool next(int i, Unit& u) const {
    if (c < 0) return false;
    const long L = (long)i * G + c; if (L >= nwg) return false;
    int wgid = (int)L;
    if (nz == 1) {
      { const int q = nwg / NXCD, r = nwg % NXCD, xcd = wgid % NXCD, off = wgid / NXCD; wgid = (xcd < r ? xcd * (q + 1) : r * (q + 1) + (xcd - r) * q) + off; }
      const int nig = WGM * nN, gid = wgid / nig, fm = gid * WGM, gsz = (nM - fm) < WGM ? (nM - fm) : WGM;
      u.pm = fm + ((wgid % nig) % gsz); u.pn = (wgid % nig) / gsz; u.z = 0;
    } else { u.z = wgid / per; const int r = wgid % per; u.pm = r % nM; u.pn = r / nM; }
    return true;
  }
};

template <class Epi, int M_, int N_, int K_, int LDA_, int NZ_, size_t SA_, size_t SB_>
__device__ __forceinline__ void gemm_phase(LAS uchar* lds, const Gemm g, const Order<M_, N_, NZ_>& S, const Epi& E) {
  const int tid = threadIdx.x, wid = __builtin_amdgcn_readfirstlane(tid >> 6), lane = tid & 63, wr = wid >> 2, wc = wid & 3, fr = lane & 15, fq = lane >> 4;
  constexpr int K = K_, nt = K / BK;
  static_assert(M_ % 256 == 0 && N_ % 256 == 0 && K_ % 128 == 0 && K_ >= 256, "gemm shape");
  unsigned voffA[2], voffB[2];
#pragma unroll
  for (int i = 0; i < 2; ++i) { int R, C; stage_rc(tid * 16 + i * 8192, R, C); const int Rb = (R & ~31) + perm32(R & 31);
    voffA[i] = (unsigned)(R * LDA_ + C) * 2u; voffB[i] = (unsigned)(Rb * K + C) * 2u; }
  size_t kstep = (size_t)(BK * 2), hstepA = (size_t)HALF * LDA_ * 2, hstepB = (size_t)HALF * K * 2;
  asm volatile("" : "+s"(kstep), "+s"(hstepA), "+s"(hstepB));
  constexpr size_t tstepA = 2 * (size_t)HALF * LDA_ * 2, tstepB = 2 * (size_t)HALF * K * 2;
  const unsigned ldsw = (unsigned)wid * 1024u;
  const int aoff = lds_byte(wr * 64 + fr, fq * 8), boff = lds_byte(wc * 32 + fr, fq * 8);
#define PG8_SA(b, h) (((b) * 2 + (h)) * HTB)
#define PG8_SB(b, h) ((4 + (b) * 2 + (h)) * HTB)
#define PG8_STAGE(bufoff, gbase, voff) do { _Pragma("unroll") for (int _i = 0; _i < 2; ++_i) \
    __builtin_amdgcn_global_load_lds((const unsigned*)((const char*)(gbase) + (voff)[_i]), (LAS unsigned*)(lds + (bufoff) + ldsw + _i * 8192), 16, 0, 0); } while (0)
#define PG8_LDA(dst, b, h) do { _Pragma("unroll") for (int m = 0; m < 4; ++m) _Pragma("unroll") for (int k = 0; k < 2; ++k) dst[m][k] = *(const LAS bf16x8*)(lds + PG8_SA(b, h) + aoff + m * 2048 + k * 1024); } while (0)
#define PG8_LDB(dst, b, h) do { _Pragma("unroll") for (int n = 0; n < 2; ++n) _Pragma("unroll") for (int k = 0; k < 2; ++k) dst[n][k] = *(const LAS bf16x8*)(lds + PG8_SB(b, h) + boff + n * 2048 + k * 1024); } while (0)
#define PG8_MMA(ai, bj, At, Bt) do { __builtin_amdgcn_s_setprio(1); _Pragma("unroll") for (int m = 0; m < 4; ++m) _Pragma("unroll") for (int n = 0; n < 2; ++n) _Pragma("unroll") for (int k = 0; k < 2; ++k) \
    acc[ai][bj][m][n] = __builtin_amdgcn_mfma_f32_16x16x32_bf16(Bt[n][k], At[m][k], acc[ai][bj][m][n], 0, 0, 0); __builtin_amdgcn_s_setprio(0); } while (0)
#define PG8_WAIT_V(n) asm volatile("s_waitcnt vmcnt(" #n ")" ::: "memory")
#define PG8_WAIT_L(n) asm volatile("s_waitcnt lgkmcnt(" #n ")" ::: "memory")
#define PG8_BAR __builtin_amdgcn_s_barrier()
#define PG8_SCHED __builtin_amdgcn_sched_barrier(0)
  Unit cur, nxt; int ui = 0;
  if (!S.next(0, cur)) return;
  f32x4 acc[2][2][4][2];
#pragma unroll
  for (int a = 0; a < 2; ++a)
#pragma unroll
    for (int b = 0; b < 2; ++b)
#pragma unroll
      for (int m = 0; m < 4; ++m)
#pragma unroll
        for (int n = 0; n < 2; ++n) acc[a][b][m][n] = (f32x4){0.f, 0.f, 0.f, 0.f};
  bf16x8 At[4][2], B0[2][2], B1[2][2];
  const char* cA = (const char*)g.A + (size_t)cur.z * SA_ + (size_t)cur.pm * tstepA;
  const char* cB = (const char*)g.Bt + (size_t)cur.z * SB_ + (size_t)cur.pn * tstepB;
  PG8_WAIT_V(0);
  LAS float* const rsl = (LAS float*)(lds + STAGE_BYTES);
  sq_t pre_v = 0;
  if (Epi::HAS_PRE) { const sq_t* pp = E.pre_ptr(); if (pp && tid < 256) pre_v = pp[cur.pm * 256 + tid]; }
  PG8_STAGE(PG8_SB(0, 0), cB, voffB); PG8_STAGE(PG8_SB(0, 1), cB + hstepB, voffB); PG8_STAGE(PG8_SA(0, 0), cA, voffA); PG8_STAGE(PG8_SA(0, 1), cA + hstepA, voffA);
  if (wr == 1) PG8_BAR;
  PG8_WAIT_V(2); PG8_BAR;
  PG8_STAGE(PG8_SB(1, 0), cB + kstep, voffB); PG8_STAGE(PG8_SA(1, 0), cA + kstep, voffA); PG8_STAGE(PG8_SB(1, 1), cB + hstepB + kstep, voffB);
  PG8_WAIT_V(6); PG8_BAR;
  for (;;) {
    const bool has_next = S.next(ui + 1, nxt);
    const char* nA = has_next ? (const char*)g.A + (size_t)nxt.z * SA_ + (size_t)nxt.pm * tstepA : cA;
    const char* nB = has_next ? (const char*)g.Bt + (size_t)nxt.z * SB_ + (size_t)nxt.pn * tstepB : cB;
#pragma nounroll
    for (int t = 0; t < nt; t += 2) {
      const bool last = (t == nt - 2);
      const char* a1 = cA + (size_t)(t + 1) * kstep;
      const char* a2 = last ? nA : cA + (size_t)(t + 2) * kstep; const char* b2 = last ? nB : cB + (size_t)(t + 2) * kstep;
      const char* a3 = a2 + kstep; const char* b3 = b2 + kstep;
      PG8_LDB(B0, 0, 0); PG8_LDB(B1, 0, 1); PG8_SCHED; PG8_LDA(At, 0, 0); PG8_STAGE(PG8_SA(1, 1), a1 + hstepA, voffA);
      PG8_WAIT_V(8); PG8_WAIT_L(0); PG8_BAR; PG8_MMA(0, 0, At, B0); PG8_MMA(0, 1, At, B1); PG8_BAR; PG8_SCHED;
      PG8_LDA(At, 0, 1); PG8_STAGE(PG8_SB(0, 0), b2, voffB); PG8_STAGE(PG8_SB(0, 1), b2 + hstepB, voffB); PG8_STAGE(PG8_SA(0, 0), a2, voffA);
      PG8_WAIT_V(8); PG8_WAIT_L(0); PG8_BAR; PG8_MMA(1, 0, At, B0); PG8_MMA(1, 1, At, B1); PG8_BAR; PG8_SCHED;
      PG8_LDB(B0, 1, 0); PG8_LDB(B1, 1, 1); PG8_SCHED; PG8_LDA(At, 1, 0); PG8_STAGE(PG8_SA(0, 1), a2 + hstepA, voffA);
      PG8_WAIT_V(8); PG8_WAIT_L(0); PG8_BAR; PG8_MMA(0, 0, At, B0); PG8_MMA(0, 1, At, B1); PG8_BAR; PG8_SCHED;
      PG8_LDA(At, 1, 1); PG8_STAGE(PG8_SB(1, 0), b3, voffB); PG8_STAGE(PG8_SB(1, 1), b3 + hstepB, voffB); PG8_STAGE(PG8_SA(1, 0), a3, voffA);
      PG8_WAIT_V(8); PG8_WAIT_L(0); PG8_BAR; PG8_MMA(1, 0, At, B0); PG8_MMA(1, 1, At, B1); PG8_BAR; PG8_SCHED;
    }
    if (Epi::HAS_PRE) { if (tid < 256) { rsl[tid] = rs_of(pre_v, E.pre_invn()); PG8_WAIT_L(0); } }
    if (wr == 0) PG8_BAR;
    E(acc, cur, wr, wc, fr, fq, rsl);
    if (!has_next) break;
#pragma unroll
    for (int a = 0; a < 2; ++a)
#pragma unroll
      for (int b = 0; b < 2; ++b)
#pragma unroll
        for (int m = 0; m < 4; ++m)
#pragma unroll
          for (int n = 0; n < 2; ++n) acc[a][b][m][n] = (f32x4){0.f, 0.f, 0.f, 0.f};
    cur = nxt; cA = nA; cB = nB; ++ui;
    if (Epi::HAS_PRE) { const sq_t* pp = E.pre_ptr(); if (pp && tid < 256) pre_v = pp[cur.pm * 256 + tid]; }
    if (wr == 1) PG8_BAR;
  }
  PG8_WAIT_V(0);
  PG8_BAR;
#undef PG8_SA
#undef PG8_SB
#undef PG8_STAGE
#undef PG8_LDA
#undef PG8_LDB
#undef PG8_MMA
#undef PG8_WAIT_V
#undef PG8_WAIT_L
#undef PG8_BAR
#undef PG8_SCHED
}
}
using pg8::Unit;
typedef f32x4 AccT[2][2][4][2];

#define EPI_HDR __device__ __forceinline__ void operator()(const AccT& acc, const Unit& u, int wr, int wc, int fr, int fq, const LAS float* rsl) const
#define NO_PRE static constexpr bool HAS_PRE = false; __device__ __forceinline__ const sq_t* pre_ptr() const { return nullptr; } __device__ __forceinline__ float pre_invn() const { return 1.f; }
#define PRE(ptr, invn) static constexpr bool HAS_PRE = true; __device__ __forceinline__ const sq_t* pre_ptr() const { return (ptr); } __device__ __forceinline__ float pre_invn() const { return (invn); }

struct EpiSwiglu {
  bf16_t* G; const sq_t* sq;
  PRE(sq, 1.f / 1024.f)
  EPI_HDR {
#pragma unroll
    for (int ai = 0; ai < 2; ++ai)
#pragma unroll
      for (int m = 0; m < 4; ++m) {
        const int row = u.pm * 256 + ai * 128 + wr * 64 + m * 16 + fr;
        const float rs = rsl[ai * 128 + wr * 64 + m * 16 + fr];
        f32x4 o0, o1;
#pragma unroll
        for (int j = 0; j < 4; ++j) { o0[j] = siluf_(acc[ai][0][m][0][j] * rs) * (acc[ai][1][m][0][j] * rs); o1[j] = siluf_(acc[ai][0][m][1][j] * rs) * (acc[ai][1][m][1][j] * rs); }
        *(u32x4*)(G + (size_t)row * FF + u.pn * 128 + wc * 32 + 8 * fq) = pack8(o0, o1);
      }
  }
};

template <int MODE> struct EpiResid {
  const float* res32; const bf16_t* res16; float* out32; bf16_t* hb; sq_t* sq_out; float alpha; const bf16_t* U; const sq_t* sq_in;
  PRE(sq_in, 1.f / 1024.f)
  EPI_HDR {
#pragma unroll
    for (int ai = 0; ai < 2; ++ai)
#pragma unroll
      for (int m = 0; m < 4; ++m) {
        const int row = u.pm * 256 + ai * 128 + wr * 64 + m * 16 + fr;
        float rs = 0.f; if (MODE == 1) rs = rsl[ai * 128 + wr * 64 + m * 16 + fr];
        float part = 0.f;
#pragma unroll
        for (int bj = 0; bj < 2; ++bj) {
          const size_t off = (size_t)row * DM + u.pn * 256 + bj * 128 + wc * 32 + 8 * fq;
          f32x4 r0, r1;
          if (res32) { r0 = *(const f32x4*)(res32 + off); r1 = *(const f32x4*)(res32 + off + 4); }
          else unpack8(*(const u32x4*)(res16 + off), r0, r1);
          f32x4 h0, h1;
          if (MODE == 0) { h0 = r0 + alpha * acc[ai][bj][m][0]; h1 = r1 + alpha * acc[ai][bj][m][1]; }
          else { f32x4 u0, u1; unpack8(*(const u32x4*)(U + off), u0, u1);
#pragma unroll
            for (int j = 0; j < 4; ++j) { h0[j] = r0[j] + u0[j] * sigmoidf_(rs * acc[ai][bj][m][0][j]); h1[j] = r1[j] + u1[j] * sigmoidf_(rs * acc[ai][bj][m][1][j]); } }
          if (out32) { *(f32x4*)(out32 + off) = h0; *(f32x4*)(out32 + off + 4) = h1; }
          if (hb) *(u32x4*)(hb + off) = pack8(h0, h1);
#pragma unroll
          for (int j = 0; j < 4; ++j) part += h0[j] * h0[j] + h1[j] * h1[j];
        }
        part += shx(part, 16); part += shx(part, 32);
        if (fq == 0) sq_add(sq_out + row, part);
      }
  }
};

struct EpiStore {
  bf16_t* O; int ldo; const sq_t* sq; float inv_n;
  PRE(sq, inv_n)
  EPI_HDR {
#pragma unroll
    for (int ai = 0; ai < 2; ++ai)
#pragma unroll
      for (int m = 0; m < 4; ++m) {
        const int row = u.pm * 256 + ai * 128 + wr * 64 + m * 16 + fr;
        const float rs = sq ? rsl[ai * 128 + wr * 64 + m * 16 + fr] : 1.f;
#pragma unroll
        for (int bj = 0; bj < 2; ++bj)
          *(u32x4*)(O + (size_t)row * ldo + u.pn * 256 + bj * 128 + wc * 32 + 8 * fq) = pack8(acc[ai][bj][m][0] * rs, acc[ai][bj][m][1] * rs);
      }
  }
};

struct EpiKV {
  bf16_t* KV; bf16_t* VT; const sq_t* sq;
  PRE(sq, 1.f / 256.f)
  EPI_HDR {
#pragma unroll
    for (int ai = 0; ai < 2; ++ai)
#pragma unroll
      for (int m = 0; m < 4; ++m) {
        const int row = u.pm * 256 + ai * 128 + wr * 64 + m * 16 + fr;
        const float rs = rsl[ai * 128 + wr * 64 + m * 16 + fr];
#pragma unroll
        for (int bj = 0; bj < 2; ++bj) {
          const int col = u.pn * 256 + bj * 128 + wc * 32 + 8 * fq;
          const u32x4 w = pack8(acc[ai][bj][m][0] * rs, acc[ai][bj][m][1] * rs);
          if (wc < 2) *(u32x4*)(KV + (size_t)row * 1024 + col) = w;
          else { bf16_t* vt = VT + ((size_t)((row >> 13) * 8 + (col >> 7)) * 64 + (col & 63)) * SEQ + (row & (SEQ - 1));
#pragma unroll
            for (int e = 0; e < 4; ++e) { vt[(size_t)(2 * e) * SEQ] = (bf16_t)(w[e] & 0xffffu); vt[(size_t)(2 * e + 1) * SEQ] = (bf16_t)(w[e] >> 16); } }
        }
      }
  }
};

struct EpiWinEven {
  bf16_t* Y; const sq_t* sq; sq_t* sq_q; sq_t* sq_kv;
  PRE(sq, 1.f / 1024.f)
  EPI_HDR {
#pragma unroll
    for (int ai = 0; ai < 2; ++ai)
#pragma unroll
      for (int m = 0; m < 4; ++m) {
        const int row = u.pm * 256 + ai * 128 + wr * 64 + m * 16 + fr;
        const float rs = rsl[ai * 128 + wr * 64 + m * 16 + fr];
#pragma unroll
        for (int bj = 0; bj < 2; ++bj) {
          const f32x4 v0 = acc[ai][bj][m][0] * rs, v1 = acc[ai][bj][m][1] * rs;
          *(u32x4*)(Y + (size_t)row * YLD + u.pn * 256 + bj * 128 + wc * 32 + 8 * fq) = pack8(v0, v1);
          const int seg = 2 * u.pn + bj;
          if (seg < 5) {
            float part = 0.f;
#pragma unroll
            for (int j = 0; j < 4; ++j) part += v0[j] * v0[j] + v1[j] * v1[j];
            part += shx(part, 16); part += shx(part, 32);
            if (fq == 0) sq_add((seg < 3 ? sq_q : sq_kv) + row, part);
          }
        }
      }
  }
};

struct EpiQ {
  bf16_t* Q; const sq_t* sq_q; const float* rope;
  PRE(sq_q, 1.f / 384.f)
  EPI_HDR {
    const float QS = 0.10206207261596575f * 1.4426950408889634f;
#pragma unroll
    for (int ai = 0; ai < 2; ++ai)
#pragma unroll
      for (int m = 0; m < 4; ++m) {
        const int row = u.pm * 256 + ai * 128 + wr * 64 + m * 16 + fr;
        const float rs = rsl[ai * 128 + wr * 64 + m * 16 + fr] * QS;
        const int pos = row & (SEQ - 1);
#pragma unroll
        for (int bj = 0; bj < 2; ++bj) {
          const int colg = u.pn * 256 + bj * 128 + wc * 32;
          f32x4 v0 = acc[ai][bj][m][0] * rs, v1 = acc[ai][bj][m][1] * rs;
          if (((colg >> 5) % 3) == 2) {
            const float* cs = rope + ((size_t)pos * 16 + 8 * (fq & 1)) * 2;
            const f32x4 c0 = *(const f32x4*)(cs), c1 = *(const f32x4*)(cs + 4), c2 = *(const f32x4*)(cs + 8), c3 = *(const f32x4*)(cs + 12);
            const float co[8] = {c0[0], c0[2], c1[0], c1[2], c2[0], c2[2], c3[0], c3[2]};
            const float si[8] = {c0[1], c0[3], c1[1], c1[3], c2[1], c2[3], c3[1], c3[3]};
#pragma unroll
            for (int j = 0; j < 4; ++j) {
              const float p0 = shx(v0[j], 32), p1 = shx(v1[j], 32);
              if (fq < 2) { v0[j] = v0[j] * co[j] - p0 * si[j]; v1[j] = v1[j] * co[4 + j] - p1 * si[4 + j]; }
              else { v0[j] = p0 * si[j] + v0[j] * co[j]; v1[j] = p1 * si[4 + j] + v1[j] * co[4 + j]; }
            }
          }
          *(u32x4*)(Q + (size_t)row * 768 + colg + 8 * fq) = pack8(v0, v1);
        }
      }
  }
};

struct EpiWinOdd {
  bf16_t* Yo; bf16_t* Upk; const sq_t* sq;
  PRE(sq, 1.f / 1024.f)
  EPI_HDR {
#pragma unroll
    for (int ai = 0; ai < 2; ++ai)
#pragma unroll
      for (int m = 0; m < 4; ++m) {
        const int row = u.pm * 256 + ai * 128 + wr * 64 + m * 16 + fr;
        const float rs = rsl[ai * 128 + wr * 64 + m * 16 + fr];
#pragma unroll
        for (int bj = 0; bj < 2; ++bj) {
          const int col = u.pn * 256 + bj * 128 + wc * 32 + 8 * fq;
          const u32x4 w = pack8(acc[ai][bj][m][0] * rs, acc[ai][bj][m][1] * rs);
          if (u.pn < 4) *(u32x4*)(Yo + (size_t)row * 1024 + col) = w;
          else { const int cu = col - 1024, g = cu >> 4, ci = cu & 15; *(u32x4*)(Upk + ((size_t)g * 1024 + (row >> 5)) * 640 + (row & 31) * 16 + ci) = w; }
        }
      }
  }
};

struct EpiZ {
  float* Z;
  NO_PRE
  EPI_HDR {
#pragma unroll
    for (int ai = 0; ai < 2; ++ai)
#pragma unroll
      for (int m = 0; m < 4; ++m) {
        const int row = u.pm * 256 + ai * 128 + wr * 64 + m * 16 + fr;
        float* p = Z + ((size_t)row * 32 + u.z) * 128 + wc * 32 + 8 * fq;
        *(f32x4*)p = acc[ai][0][m][0]; *(f32x4*)(p + 4) = acc[ai][0][m][1];
      }
  }
};

struct EpiRG {
  bf16_t* la; bf16_t* bx; const bf16_t* xc; const float* b_a; const float* b_i; const float* c8sp;
  NO_PRE
  EPI_HDR {
    const int c0 = u.pn * 128 + wc * 32 + 8 * fq;
    float ba[8], bi[8], cs[8];
#pragma unroll
    for (int j = 0; j < 8; ++j) { ba[j] = b_a[c0 + j]; bi[j] = b_i[c0 + j]; cs[j] = c8sp[c0 + j]; }
#pragma unroll
    for (int ai = 0; ai < 2; ++ai)
#pragma unroll
      for (int m = 0; m < 4; ++m) {
        const int row = u.pm * 256 + ai * 128 + wr * 64 + m * 16 + fr;
        f32x4 x0, x1; unpack8(*(const u32x4*)(xc + (size_t)row * 512 + c0), x0, x1);
        f32x4 l0, l1, o0, o1;
#pragma unroll
        for (int j = 0; j < 4; ++j) {
          { const float r = sigmoidf_(acc[ai][0][m][0][j] + ba[j]), ig = sigmoidf_(acc[ai][1][m][0][j] + bi[j]);
            const float lg = -cs[j] * r; l0[j] = lg; o0[j] = __builtin_amdgcn_sqrtf(one_minus_exp(2.f * lg)) * (ig * x0[j]); }
          { const float r = sigmoidf_(acc[ai][0][m][1][j] + ba[4 + j]), ig = sigmoidf_(acc[ai][1][m][1][j] + bi[4 + j]);
            const float lg = -cs[4 + j] * r; l1[j] = lg; o1[j] = __builtin_amdgcn_sqrtf(one_minus_exp(2.f * lg)) * (ig * x1[j]); }
        }
        *(u32x4*)(la + (size_t)row * 512 + c0) = pack8(l0, l1);
        *(u32x4*)(bx + (size_t)row * 512 + c0) = pack8(o0, o1);
      }
  }
};

struct EpiS5Y {
  bf16_t* yg; const bf16_t* Upk; const float* dpar;
  NO_PRE
  EPI_HDR {
    const int g = u.z;
#pragma unroll
    for (int ai = 0; ai < 2; ++ai)
#pragma unroll
      for (int m = 0; m < 4; ++m) {
        const int row = u.pm * 256 + ai * 128 + wr * 64 + m * 16 + fr;
#pragma unroll
        for (int bj = 0; bj < 2; ++bj) {
          const int col = u.pn * 256 + bj * 128 + wc * 32 + 8 * fq, t = col >> 4, co = col & 15;
          f32x4 u0, u1; unpack8(*(const u32x4*)(Upk + ((size_t)g * 1024 + row) * 640 + col), u0, u1);
          const f32x4 d0 = *(const f32x4*)(dpar + g * 16 + co), d1 = *(const f32x4*)(dpar + g * 16 + co + 4);
          f32x4 y0, y1;
#pragma unroll
          for (int j = 0; j < 4; ++j) { y0[j] = geluf_(acc[ai][bj][m][0][j] + d0[j] * u0[j]); y1[j] = geluf_(acc[ai][bj][m][1][j] + d1[j] * u1[j]); }
          *(u32x4*)(yg + ((size_t)row * 32 + t) * 512 + g * 16 + co) = pack8(y0, y1);
        }
      }
  }
};

struct EpiGLU {
  bf16_t* mix; const bf16_t* yg; const float* b;
  NO_PRE
  EPI_HDR {
#pragma unroll
    for (int ai = 0; ai < 2; ++ai)
#pragma unroll
      for (int m = 0; m < 4; ++m) {
        const int row = u.pm * 256 + ai * 128 + wr * 64 + m * 16 + fr;
#pragma unroll
        for (int bj = 0; bj < 2; ++bj) {
          const int col = u.pn * 256 + bj * 128 + wc * 32 + 8 * fq;
          f32x4 y0, y1; unpack8(*(const u32x4*)(yg + (size_t)row * 512 + col), y0, y1);
          const f32x4 b0 = *(const f32x4*)(b + col), b1 = *(const f32x4*)(b + col + 4);
          f32x4 o0, o1;
#pragma unroll
          for (int j = 0; j < 4; ++j) { o0[j] = y0[j] * sigmoidf_(acc[ai][bj][m][0][j] + b0[j]); o1[j] = y1[j] * sigmoidf_(acc[ai][bj][m][1][j] + b1[j]); }
          *(u32x4*)(mix + (size_t)row * 1024 + 512 + col) = pack8(o0, o1);
        }
      }
  }
};

#define XB_TMO      128
#define XB_XCNT(j)  (256  + 64 * (j))
#define XB_XSUB(j)  (1280 + 64 * (j))
#define XB_XGEN(j)  (2304 + 64 * (j))
#define XB_TOP      3328
#define XB_TOPGEN   3392
#define XCD_BAR_WORDS 3456
#define XB_SPIN_CAP (1u << 18)

__device__ __forceinline__ unsigned xb_ld(unsigned* p)              { return __hip_atomic_load(p, __ATOMIC_RELAXED, __HIP_MEMORY_SCOPE_AGENT); }
__device__ __forceinline__ unsigned xb_add(unsigned* p, unsigned v) { return __hip_atomic_fetch_add(p, v, __ATOMIC_RELAXED, __HIP_MEMORY_SCOPE_AGENT); }
__device__ __forceinline__ unsigned xb_xcc_id() { return (unsigned)__builtin_amdgcn_s_getreg((3 << 11) | 20) & 0xFu; }
#define XB_SPIN(cond, bar) do { unsigned _sp = 0; while (cond) { __builtin_amdgcn_s_sleep(1); \
    if ((++_sp & 255u) == 0u) { if (xb_ld(&(bar)[XB_TMO])) break; if (_sp > XB_SPIN_CAP) { atomicAdd(&(bar)[XB_TMO], 1u); break; } } } } while (0)

struct XcdBarrier {
    unsigned* bar; unsigned x;
    volatile LAS unsigned* st;
};

__device__ __forceinline__ XcdBarrier xcd_barrier_post(unsigned* bar, volatile LAS unsigned* st) {
    XcdBarrier b; b.bar = bar; b.x = xb_xcc_id(); b.st = st;
    if (threadIdx.x == 0) (void)xb_add(&bar[XB_XCNT(b.x)], 1u);
    return b;
}
__device__ __forceinline__ void xcd_barrier_complete(unsigned* bar, unsigned x, unsigned& nloc, unsigned& nx) {
    const unsigned G = gridDim.x * gridDim.y * gridDim.z;
    unsigned sum, cnt, mine, sp = 0u;
    for (;;) {
        sum = 0u; cnt = 0u; mine = 0u;
#pragma unroll
        for (unsigned j = 0; j < 16; ++j) { const unsigned c = xb_ld(&bar[XB_XCNT(j)]); sum += c; cnt += (c > 0u) ? 1u : 0u; mine = (j == x) ? c : mine; }
        if (sum == G) break;
        __builtin_amdgcn_s_sleep(1);
        if ((++sp & 255u) == 0u) { if (xb_ld(&bar[XB_TMO])) break; if (sp > XB_SPIN_CAP) { atomicAdd(&bar[XB_TMO], 1u); break; } }
    }
    nloc = mine > 0u ? mine : 1u; nx = cnt > 0u ? cnt : 1u;
}

__device__ __forceinline__ void xcd_barrier(const XcdBarrier& b) {
    asm volatile("s_waitcnt vmcnt(0)" ::: "memory");
    __syncthreads();
    if (threadIdx.x == 0) {
        unsigned* bar = b.bar;
        __builtin_amdgcn_s_waitcnt(0);
        unsigned nloc = b.st[0], nx = b.st[1];
        if (nloc == 0u) { xcd_barrier_complete(bar, b.x, nloc, nx); b.st[0] = nloc; b.st[1] = nx; }
        const unsigned old = xb_add(&bar[XB_XSUB(b.x)], 1u);
        const unsigned gen = old / nloc;
        if (old + 1u == (gen + 1u) * nloc) {
            __builtin_amdgcn_fence(__ATOMIC_RELEASE, "agent");
            asm volatile("s_waitcnt vmcnt(0)" ::: "memory");
            const unsigned og = xb_add(&bar[XB_TOP], 1u);
            const unsigned tg = og / nx;
            if (og + 1u == (tg + 1u) * nx) xb_add(&bar[XB_TOPGEN], 1u);
            else XB_SPIN(xb_ld(&bar[XB_TOPGEN]) == tg, bar);
            __builtin_amdgcn_fence(__ATOMIC_ACQUIRE, "agent");
            xb_add(&bar[XB_XGEN(b.x)], 1u);
            asm volatile("s_waitcnt vmcnt(0)" ::: "memory");
        } else {
            XB_SPIN(xb_ld(&bar[XB_XGEN(b.x)]) == gen, bar);
            __builtin_amdgcn_fence(__ATOMIC_ACQUIRE, "agent");
            asm volatile("s_waitcnt vmcnt(0)" ::: "memory");
        }
    }
    __syncthreads();
}

struct Frame {
  LAS uchar* lds; int tid, lane, wave, bid, G;
  sq_t* stat; uchar* ws; float* out; XcdBarrier xb;
};
__device__ __forceinline__ sq_t* statp(const Frame& F, int i) { return F.stat + (size_t)i * T; }
template <int M_, int N_, int K_, int LDA_, int NZ_ = 1, size_t SA_ = 0, size_t SB_ = 0, class Epi>
__device__ __forceinline__ void run_gemm(const Frame& F, const bf16_t* A, const bf16_t* Bt, const Epi& E, int Gsub = -1, int c = -2) {
  pg8::Order<M_, N_, NZ_> S; S.init(Gsub < 0 ? F.G : Gsub, c == -2 ? F.bid : c);
  pg8::Gemm g; g.A = A; g.Bt = Bt;
  pg8::gemm_phase<Epi, M_, N_, K_, LDA_, NZ_, SA_, SB_>(F.lds, g, S, E);
}

struct TJob { const float* src; const float* scale; bf16_t* dst; int K, N, map; };
__device__ __forceinline__ int rowmap(int map, int n) {
  if (map == 0) return n;
  if (map == 1) return 256 * (n >> 7) + (n & 127);
  if (map == 2) return 256 * (n >> 7) + 128 + (n & 127);
  if (n < 640) return n;
  if (n < 672) return YC_KR + (n - 640);
  if (n < 1696) return n - 32;
  if (n < 1712) return YC_GLOW + (n - 1696);
  return YC_GR + (n - 1712);
}
constexpr int NJOB = 23;
__device__ __forceinline__ TJob tjob(const Frame& F, int j) {
  bf16_t* W = (bf16_t*)(F.ws + WS_W);
  TJob t; t.scale = nullptr; t.map = 0;
  if (j < 12) {
    const int q = j / 3, which = j % 3, l = q >> 1, ab = q & 1;
    const float* nrm = IN_(ab ? 7 : 2) + l * 1024;
    if (which == 0) { t.src = IN_(ab ? 8 : 3) + (size_t)l * 1024 * FF; t.scale = nrm; t.dst = (bf16_t*)((uchar*)W + WO_W13 + q * W13_B); t.K = 1024; t.N = FF; t.map = 1; }
    else if (which == 1) { t.src = IN_(ab ? 9 : 4) + (size_t)l * 1024 * FF; t.scale = nrm; t.dst = (bf16_t*)((uchar*)W + WO_W13 + q * W13_B); t.K = 1024; t.N = FF; t.map = 2; }
    else { t.src = IN_(ab ? 10 : 5) + (size_t)l * FF * 1024; t.dst = (bf16_t*)((uchar*)W + WO_W2 + q * W2_B); t.K = FF; t.N = 1024; }
  } else if (j < 16) {
    const int l = (j - 12) >> 1, which = (j - 12) & 1;
    if (which == 0) { t.src = IN_(12) + (size_t)l * 1024 * 1024; t.scale = IN_(11) + l * 1024; t.dst = (bf16_t*)((uchar*)W + WO_WG + (size_t)l * 1024 * 1024 * 2); t.K = 1024; t.N = 1024; }
    else { t.src = IN_(13) + (size_t)l * 256 * 1024; t.dst = (bf16_t*)((uchar*)W + WO_WUP + (size_t)l * 1024 * 256 * 2); t.K = 256; t.N = 1024; }
  } else if (j == 16) { t.src = IN_(14); t.scale = IN_(6); t.dst = (bf16_t*)((uchar*)W + WO_WINE); t.K = 1024; t.N = 2224; t.map = 3; }
  else if (j == 17) { t.src = IN_(16); t.scale = IN_(15); t.dst = (bf16_t*)((uchar*)W + WO_WQ); t.K = 384; t.N = 768; }
  else if (j == 18) { t.src = IN_(18); t.scale = IN_(17); t.dst = (bf16_t*)((uchar*)W + WO_WKV); t.K = 256; t.N = 1024; }
  else if (j == 19) { t.src = IN_(22); t.dst = (bf16_t*)((uchar*)W + WO_WOUTE); t.K = 1024; t.N = 1024; }
  else if (j == 20) { t.src = IN_(23); t.scale = IN_(6) + 1024; t.dst = (bf16_t*)((uchar*)W + WO_WINO); t.K = 1024; t.N = 1536; }
  else if (j == 21) { t.src = IN_(39); t.dst = (bf16_t*)((uchar*)W + WO_WGLU); t.K = 512; t.N = 512; }
  else { t.src = IN_(41); t.dst = (bf16_t*)((uchar*)W + WO_WOUTO); t.K = 1024; t.N = 1024; }
  return t;
}
__device__ __forceinline__ int tjob_tiles(int K, int N) { return (K >> 7) * ((N + 63) >> 6); }

struct TLoad { f32x4 v[4]; float s[4]; };
__device__ __forceinline__ TLoad trans_load(const TJob& j, int tile, int tid) {
  const int ntn = (j.N + 63) >> 6, kt = tile / ntn, nt_ = tile % ntn, k0 = kt * 128, n0 = nt_ * 64;
  TLoad L;
#pragma unroll
  for (int i = 0; i < 4; ++i) {
    const int kk = (tid >> 4) + 32 * i, n4 = (tid & 15) * 4;
    L.v[i] = (f32x4){0.f, 0.f, 0.f, 0.f};
    if (n0 + n4 < j.N) L.v[i] = *(const f32x4*)(j.src + (size_t)(k0 + kk) * j.N + n0 + n4);
    L.s[i] = j.scale ? j.scale[k0 + kk] : 1.f;
  }
  return L;
}
__device__ __forceinline__ void trans_store(const TJob& j, int tile, const TLoad& L, LAS float* sm, int tid) {
  const int ntn = (j.N + 63) >> 6, kt = tile / ntn, nt_ = tile % ntn, k0 = kt * 128, n0 = nt_ * 64;
#pragma unroll
  for (int i = 0; i < 4; ++i) {
    const int kk = (tid >> 4) + 32 * i, n4 = (tid & 15) * 4;
#pragma unroll
    for (int e = 0; e < 4; ++e) sm[kk * 65 + n4 + e] = L.v[i][e] * L.s[i];
  }
  __syncthreads();
  { const int n = tid >> 3, k8 = (tid & 7) * 8;
    if (n0 + n < j.N) {
      bf16_t* drow = j.dst + (size_t)rowmap(j.map, n0 + n) * j.K + k0;
#pragma unroll
      for (int ps = 0; ps < 2; ++ps) {
        f32x4 a, b;
#pragma unroll
        for (int e = 0; e < 4; ++e) { a[e] = sm[(64 * ps + k8 + e) * 65 + n]; b[e] = sm[(64 * ps + k8 + 4 + e) * 65 + n]; }
        *(u32x4*)(drow + 64 * ps + k8) = pack8(a, b);
      }
    } }
  __syncthreads();
}
__host__ __device__ constexpr int job_tiles(int j) {
  return j < 12 ? 352 : (j == 12 || j == 14) ? 128 : (j == 13 || j == 15) ? 32 : j == 16 ? 280 : j == 17 ? 36 : j == 18 ? 32 : j == 19 ? 128 : j == 20 ? 192 : j == 21 ? 32 : 128;
}
__device__ __forceinline__ bool tile_lookup(const Frame& F, int gt, TJob& tj, int& tile) {
  int base = 0, jf = -1;
#pragma unroll
  for (int j = 0; j < NJOB; ++j) { const int n = job_tiles(j); if (jf < 0 && gt < base + n) { jf = j; tile = gt - base; } base += n; }
  if (jf < 0) return false;
  tj = tjob(F, jf);
  return true;
}

__device__ __forceinline__ void s5_group_item(const Args& a, const Frame& F, int g) {
  LAS float* sm = (LAS float*)F.lds;
  LAS float* ApR = sm;
  LAS float* ApI = sm + 2112;
  LAS float* bbR = sm + 4224;
  LAS float* bbI = sm + 5248;
  LAS float* CR = sm + 6272;
  LAS float* CI = sm + 7296;
  LAS float* Kt = sm + 8320;
  const int tid = F.tid;
  const float* a_re = IN_(31); const float* a_im = IN_(32); const float* log_dt = IN_(33);
  const float* b_re = IN_(34); const float* b_im = IN_(35); const float* c_re = IN_(36); const float* c_im = IN_(37);
  if (tid < 64) {
    const int p = tid;
    const double dt = exp((double)log_dt[g]);
    const double lr = a_re[g * 64 + p], li = a_im[g * 64 + p];
    const double mag = exp(lr * dt); double sn, cs; sincos_acc(li * dt, sn, cs);
    const double ar = mag * cs, aim = mag * sn;
    const double den = lr * lr + li * li, nr = ar - 1.0, ni = aim;
    const double cr = (nr * lr + ni * li) / den, ci = (ni * lr - nr * li) / den;
    double pr = 1.0, pi = 0.0;
    for (int t = 0; t <= 32; ++t) { ApR[p * 33 + t] = (float)pr; ApI[p * 33 + t] = (float)pi; const double nr2 = pr * ar - pi * aim, ni2 = pr * aim + pi * ar; pr = nr2; pi = ni2; }
    float* AL = (float*)(F.ws + WS_AL);
    AL[(g * 64 + p) * 2] = ApR[p * 33 + 32]; AL[(g * 64 + p) * 2 + 1] = ApI[p * 33 + 32];
    for (int c = 0; c < 16; ++c) {
      const double br = b_re[(g * 64 + p) * 16 + c], bi = b_im[(g * 64 + p) * 16 + c];
      bbR[p * 16 + c] = (float)(cr * br - ci * bi); bbI[p * 16 + c] = (float)(cr * bi + ci * br);
    }
  }
  for (int i = tid; i < 1024; i += NTHR) { CR[i] = c_re[g * 1024 + i]; CI[i] = c_im[g * 1024 + i]; }
  __syncthreads();
  { const int tau = tid >> 4, co = tid & 15;
    float acc16[16];
#pragma unroll
    for (int ci = 0; ci < 16; ++ci) acc16[ci] = 0.f;
    for (int p = 0; p < 64; ++p) {
      const float cr = CR[co * 64 + p], ci_ = CI[co * 64 + p], ar = ApR[p * 33 + tau], ai = ApI[p * 33 + tau];
      const float xr = cr * ar - ci_ * ai, xi = cr * ai + ci_ * ar;
#pragma unroll
      for (int ci = 0; ci < 16; ++ci) acc16[ci] += xr * bbR[p * 16 + ci] - xi * bbI[p * 16 + ci];
    }
#pragma unroll
    for (int ci = 0; ci < 16; ++ci) Kt[tid * 16 + ci] = acc16[ci];
  }
  __syncthreads();
  bf16_t* MW = (bf16_t*)(F.ws + WS_W + WO_MW) + (size_t)g * 512 * 640;
  for (int it = tid; it < 512 * 80; it += NTHR) {
    const int row = it / 80, cg8 = it % 80, t = row >> 4, co = row & 15;
    float v[8];
    if (cg8 < 64) { const int s = cg8 >> 1, ci0 = (cg8 & 1) * 8;
#pragma unroll
      for (int j = 0; j < 8; ++j) v[j] = (s <= t) ? Kt[(t - s) * 256 + co * 16 + ci0 + j] : 0.f;
    } else {
#pragma unroll
      for (int j = 0; j < 8; ++j) { const int q = (cg8 - 64) * 8 + j, p = q & 63;
        const float xr = CR[co * 64 + p] * ApR[p * 33 + t + 1] - CI[co * 64 + p] * ApI[p * 33 + t + 1];
        const float xi = CR[co * 64 + p] * ApI[p * 33 + t + 1] + CI[co * 64 + p] * ApR[p * 33 + t + 1];
        v[j] = (q < 64) ? xr : -xi; }
    }
    *(u32x4*)(MW + (size_t)row * 640 + cg8 * 8) = (u32x4){pk2(v[0], v[1]), pk2(v[2], v[3]), pk2(v[4], v[5]), pk2(v[6], v[7])};
  }
  bf16_t* WZ = (bf16_t*)(F.ws + WS_W + WO_WZ) + (size_t)g * 256 * 512;
  for (int it = tid; it < 256 * 64; it += NTHR) {
    const int row = it >> 6, cg8 = it & 63, s = cg8 >> 1, ci0 = (cg8 & 1) * 8;
    float v[8];
#pragma unroll
    for (int j = 0; j < 8; ++j) {
      if (row < 128) { const int p = row & 63; const float pr = ApR[p * 33 + 31 - s], pi = ApI[p * 33 + 31 - s], br = bbR[p * 16 + ci0 + j], bi = bbI[p * 16 + ci0 + j];
        v[j] = (row < 64) ? (pr * br - pi * bi) : (pr * bi + pi * br); }
      else v[j] = 0.f;
    }
    *(u32x4*)(WZ + (size_t)row * 512 + cg8 * 8) = (u32x4){pk2(v[0], v[1]), pk2(v[2], v[3]), pk2(v[4], v[5]), pk2(v[6], v[7])};
  }
  __syncthreads();
}

__device__ __forceinline__ void p0_prologue(const Args& a, const Frame& F) {
  const int tid = F.tid, gtid = F.bid * NTHR + tid, gthreads = F.G * NTHR;
  if (F.G < 160) { for (int g = F.bid; g < 32; g += F.G) s5_group_item(a, F, g); }
  { TJob cj, nj; int ct = 0, nt2 = 0; int gt = F.bid;
    bool have = tile_lookup(F, gt, cj, ct);
    TLoad cl; if (have) cl = trans_load(cj, ct, tid);
    while (have) {
      const bool hn = tile_lookup(F, gt + F.G, nj, nt2);
      TLoad nl; if (hn) nl = trans_load(nj, nt2, tid);
      trans_store(cj, ct, cl, (LAS float*)F.lds, tid);
      if (hn) { cj = nj; ct = nt2; cl = nl; }
      have = hn; gt += F.G;
    } }
  { const float* __restrict__ x = IN_(0); bf16_t* __restrict__ hb = (bf16_t*)(F.ws + WS_HBB); sq_t* __restrict__ sq = statp(F, 0);
    const int gw = F.bid * 8 + F.wave, nw = F.G * 8;
    for (int row = gw; row < T; row += 2 * nw) {
      const int row2 = row + nw; const bool two = row2 < T;
      f32x4 v[4], w[4];
#pragma unroll
      for (int i = 0; i < 4; ++i) { v[i] = *(const f32x4*)(x + (size_t)row * DM + (F.lane + 64 * i) * 4); w[i] = two ? *(const f32x4*)(x + (size_t)row2 * DM + (F.lane + 64 * i) * 4) : (f32x4){0.f, 0.f, 0.f, 0.f}; }
      float ss = 0.f, ss2 = 0.f;
#pragma unroll
      for (int i = 0; i < 4; ++i) { ss += v[i][0] * v[i][0] + v[i][1] * v[i][1] + v[i][2] * v[i][2] + v[i][3] * v[i][3]; ss2 += w[i][0] * w[i][0] + w[i][1] * w[i][1] + w[i][2] * w[i][2] + w[i][3] * w[i][3];
        *(u32x2*)(hb + (size_t)row * DM + (F.lane + 64 * i) * 4) = (u32x2){pk2(v[i][0], v[i][1]), pk2(v[i][2], v[i][3])};
        if (two) *(u32x2*)(hb + (size_t)row2 * DM + (F.lane + 64 * i) * 4) = (u32x2){pk2(w[i][0], w[i][1]), pk2(w[i][2], w[i][3])}; }
#pragma unroll
      for (int o = 32; o >= 1; o >>= 1) { ss += shx(ss, o); ss2 += shx(ss2, o); }
      if (F.lane == 0) { sq[row] = (sq_t)(ss * 16777216.f + 0.5f); if (two) sq[row2] = (sq_t)(ss2 * 16777216.f + 0.5f); }
    } }
  { const float* __restrict__ p = IN_(1); bf16_t* __restrict__ pb = (bf16_t*)(F.ws + WS_PB);
#pragma unroll 4
    for (size_t i = gtid; i < (size_t)2 * T * 256 / 8; i += gthreads) {
      const f32x4 v0 = *(const f32x4*)(p + i * 8), v1 = *(const f32x4*)(p + i * 8 + 4);
      *(u32x4*)(pb + i * 8) = pack8(v0, v1); } }
  { float* rope = (float*)(F.ws + WS_ROPE);
    for (int i = gtid; i < SEQ * 16; i += gthreads) {
      const int pos = i >> 4, k = i & 15;
      const float inv = (float)exp(-(double)k / 16.0 * 9.210340371976184);
      const float ang = (float)pos * inv;
      double s, c; sincos_acc((double)ang, s, c);
      rope[i * 2] = (float)c; rope[i * 2 + 1] = (float)s; } }
  { float* c8 = (float*)(F.ws + WS_C8SP); const float* lam = IN_(30);
    for (int i = gtid; i < 512; i += gthreads) c8[i] = (float)(8.0 * log1p(exp(-(double)lam[i]))); }
  { bf16_t* Wrg = (bf16_t*)(F.ws + WS_W + WO_WRG); const float* w_a = IN_(26); const float* w_i = IN_(28);
    for (int it = gtid; it < 1024 * 64; it += gthreads) {
      const int n = it >> 6, k8 = (it & 63) * 8, within = n & 255, bj = within >> 7, c = (n >> 8) * 128 + (within & 127), hb_ = c >> 6, jj = c & 63;
      float v[8];
#pragma unroll
      for (int e = 0; e < 8; ++e) { const int k = k8 + e; v[e] = ((k >> 6) == hb_) ? (bj ? w_i : w_a)[(hb_ * 64 + (k & 63)) * 64 + jj] : 0.f; }
      *(u32x4*)(Wrg + (size_t)n * 512 + k8) = (u32x4){pk2(v[0], v[1]), pk2(v[2], v[3]), pk2(v[4], v[5]), pk2(v[6], v[7])};
    } }
  { bf16_t* W = (bf16_t*)(F.ws + WS_W + WO_WINE);
    for (int it = gtid; it < 80 * 128; it += gthreads) *(u32x4*)(W + (size_t)(2224 + it / 128) * 1024 + (it % 128) * 8) = (u32x4){0u, 0u, 0u, 0u}; }
}

__device__ __forceinline__ f32x4 mma_lds(f32x4 acc, const LAS bf16_t* A, int lda, const LAS bf16_t* Bt, int ldb, int klen, int lane) {
  const int r = lane & 15, q = lane >> 4;
  for (int k0 = 0; k0 < klen; k0 += 32) {
    const bf16x8 a = *(const LAS bf16x8*)(A + r * lda + k0 + 8 * q);
    const bf16x8 b = *(const LAS bf16x8*)(Bt + r * ldb + k0 + 8 * q);
    acc = __builtin_amdgcn_mfma_f32_16x16x32_bf16(a, b, acc, 0, 0, 0);
  }
  return acc;
}

constexpr int GL_GB = 0;
constexpr int GL_GL = 16384;
constexpr int GL_WG = 20480;
constexpr int GL_QE = 24832;
constexpr int GL_KE = 34048;
constexpr int GL_VT = 43264;
constexpr int GL_ST = 61696;
constexpr int GL_ATT = 80128;
constexpr int GL_OF = 89344;
__device__ __forceinline__ float logsig(float z) { return fminf(z, 0.f) - __logf(1.f + fexp(-fabsf(z))); }

__device__ __forceinline__ void gla_gates(const Args& a, const Frame& F, const bf16_t* Y, int tok0, int h) {
  LAS float* gb = (LAS float*)(F.lds + GL_GB); LAS float* gl = (LAS float*)(F.lds + GL_GL); LAS float* wg = (LAS float*)(F.lds + GL_WG);
  const int tid = F.tid;
  const float* wgu = IN_(19); const float* bg = IN_(20);
  { const int c = tid >> 3, r2 = (tid & 7) * 2; const unsigned w = *(const unsigned*)(Y + (size_t)(tok0 + c) * YLD + YC_GLOW + r2); gl[c * 16 + r2] = bf_lo(w); gl[c * 16 + r2 + 1] = bf_hi(w); }
  for (int i = tid; i < 1024; i += NTHR) wg[i] = wgu[(i >> 6) * 256 + h * 64 + (i & 63)];
  if (tid < 64) wg[1024 + tid] = bg[h * 64 + tid];
  __syncthreads();
  { const int c = tid >> 3, d8 = (tid & 7) * 8;
#pragma unroll
    for (int j = 0; j < 8; ++j) { float z = wg[1024 + d8 + j];
#pragma unroll
      for (int r = 0; r < 16; ++r) z += gl[c * 16 + r] * wg[r * 64 + d8 + j];
      gb[c * 64 + d8 + j] = logsig(z) * (1.f / 16.f); } }
  __syncthreads();
  { const int d = tid & 63, seg = tid >> 6; float s = 0.f;
#pragma unroll
    for (int c = 0; c < 8; ++c) { s += gb[(8 * seg + c) * 64 + d]; gb[(8 * seg + c) * 64 + d] = s; }
    __syncthreads();
    float pre = 0.f;
    for (int sg = 0; sg < seg; ++sg) pre += gb[(8 * sg + 7) * 64 + d];
    __syncthreads();
#pragma unroll
    for (int c = 0; c < 8; ++c) gb[(8 * seg + c) * 64 + d] += pre; }
  __syncthreads();
}

__device__ __forceinline__ void gla_part1(const Args& a, const Frame& F, int item) {
  const bf16_t* Y = (const bf16_t*)(F.ws + WS_Y); bf16_t* CKV = (bf16_t*)(F.ws + WS_CKV) + (size_t)item * 8192; float* decay = (float*)(F.ws + WS_DECAY) + item * 64;
  const int b = item >> 9, h = (item >> 7) & 3, n = item & 127, tok0 = b * SEQ + n * 64, tid = F.tid, lane = F.lane, w = F.wave;
  LAS float* gb = (LAS float*)(F.lds + GL_GB); LAS bf16_t* keT = (LAS bf16_t*)(F.lds + GL_KE); LAS bf16_t* vT = (LAS bf16_t*)(F.lds + GL_VT);
  gla_gates(a, F, Y, tok0, h);
  { const int c = tid & 63, d8 = (tid >> 6) * 8; f32x4 k0, k1; unpack8(*(const u32x4*)(Y + (size_t)(tok0 + c) * YLD + YC_GK + h * 64 + d8), k0, k1);
#pragma unroll
    for (int j = 0; j < 8; ++j) { const float kv = (j < 4 ? k0[j] : k1[j - 4]) * fexp(gb[63 * 64 + d8 + j] - gb[c * 64 + d8 + j]); keT[(d8 + j) * 72 + c] = f2bf1(kv); } }
#pragma unroll
  for (int i = 0; i < 2; ++i) { const int c = tid & 63, e8 = ((tid >> 6) + 8 * i) * 8; const u32x4 wv = *(const u32x4*)(Y + (size_t)(tok0 + c) * YLD + YC_GV + h * 128 + e8);
#pragma unroll
    for (int j = 0; j < 4; ++j) { vT[(e8 + 2 * j) * 72 + c] = (bf16_t)(wv[j] & 0xffffu); vT[(e8 + 2 * j + 1) * 72 + c] = (bf16_t)(wv[j] >> 16); } }
  if (tid < 64) decay[tid] = fexp(gb[63 * 64 + tid]);
  __syncthreads();
#pragma unroll
  for (int nt_ = 0; nt_ < 4; ++nt_) {
    f32x4 acc = {0.f, 0.f, 0.f, 0.f};
    acc = mma_lds(acc, vT + 16 * w * 72, 72, keT + 16 * nt_ * 72, 72, 64, lane);
#pragma unroll
    for (int j = 0; j < 4; ++j) CKV[(16 * w + 4 * (lane >> 4) + j) * 64 + 16 * nt_ + (lane & 15)] = f2bf1(acc[j]);
  }
  __syncthreads();
}

__device__ __forceinline__ void gla_scan(const Args& a, const Frame& F) {
  bf16_t* CKV = (bf16_t*)(F.ws + WS_CKV); const float* decay = (const float*)(F.ws + WS_DECAY);
  for (int gid = F.bid * NTHR + F.tid; gid < 16 * 8192; gid += F.G * NTHR) {
    const int bh = gid >> 13, el = gid & 8191, d = el & 63;
    float st = 0.f;
    for (int n = 0; n < 128; n += 16) {
      float v[16], dc[16];
#pragma unroll
      for (int i = 0; i < 16; ++i) { const int item = bh * 128 + n + i; v[i] = bf1(CKV[(size_t)item * 8192 + el]); dc[i] = decay[item * 64 + d]; }
#pragma unroll
      for (int i = 0; i < 16; ++i) { const int item = bh * 128 + n + i; CKV[(size_t)item * 8192 + el] = f2bf1(st); st = dc[i] * st + v[i]; }
    }
  }
}

__device__ __forceinline__ void gla_part3(const Args& a, const Frame& F, int item) {
  const bf16_t* Y = (const bf16_t*)(F.ws + WS_Y); const bf16_t* CKV = (const bf16_t*)(F.ws + WS_CKV) + (size_t)item * 8192; bf16_t* mix = (bf16_t*)(F.ws + WS_HBB);
  const int b = item >> 9, h = (item >> 7) & 3, n = item & 127, tok0 = b * SEQ + n * 64, tid = F.tid, lane = F.lane, w = F.wave;
  LAS float* gb = (LAS float*)(F.lds + GL_GB); LAS bf16_t* qe = (LAS bf16_t*)(F.lds + GL_QE); LAS bf16_t* ke = (LAS bf16_t*)(F.lds + GL_KE);
  LAS bf16_t* vT = (LAS bf16_t*)(F.lds + GL_VT); LAS bf16_t* stT = (LAS bf16_t*)(F.lds + GL_ST); LAS bf16_t* att = (LAS bf16_t*)(F.lds + GL_ATT); LAS float* of = (LAS float*)(F.lds + GL_OF);
  gla_gates(a, F, Y, tok0, h);
  { const int c = tid >> 3, d8 = (tid & 7) * 8; f32x4 q0, q1, k0, k1;
    unpack8(*(const u32x4*)(Y + (size_t)(tok0 + c) * YLD + YC_GQ + h * 64 + d8), q0, q1);
    unpack8(*(const u32x4*)(Y + (size_t)(tok0 + c) * YLD + YC_GK + h * 64 + d8), k0, k1);
#pragma unroll
    for (int j = 0; j < 4; ++j) { const float b0 = gb[c * 64 + d8 + j], b1 = gb[c * 64 + d8 + 4 + j];
      q0[j] *= 0.125f * fexp(b0); q1[j] *= 0.125f * fexp(b1); k0[j] *= fexp(-b0); k1[j] *= fexp(-b1); }
    *(LAS u32x4*)(qe + c * 72 + d8) = pack8(q0, q1); *(LAS u32x4*)(ke + c * 72 + d8) = pack8(k0, k1); }
#pragma unroll
  for (int i = 0; i < 2; ++i) { const int c = tid & 63, e8 = ((tid >> 6) + 8 * i) * 8; const u32x4 wv = *(const u32x4*)(Y + (size_t)(tok0 + c) * YLD + YC_GV + h * 128 + e8);
#pragma unroll
    for (int j = 0; j < 4; ++j) { vT[(e8 + 2 * j) * 72 + c] = (bf16_t)(wv[j] & 0xffffu); vT[(e8 + 2 * j + 1) * 72 + c] = (bf16_t)(wv[j] >> 16); } }
#pragma unroll
  for (int i = 0; i < 2; ++i) { const int q = tid + NTHR * i, e = q >> 3, d8 = (q & 7) * 8; *(LAS u32x4*)(stT + e * 72 + d8) = *(const u32x4*)(CKV + e * 64 + d8); }
  __syncthreads();
#pragma unroll
  for (int i = 0; i < 2; ++i) {
    const int tl = 2 * w + i, mt = tl >> 2, nt_ = tl & 3;
    f32x4 acc = {0.f, 0.f, 0.f, 0.f};
    if (nt_ <= mt) acc = mma_lds(acc, qe + 16 * mt * 72, 72, ke + 16 * nt_ * 72, 72, 64, lane);
#pragma unroll
    for (int j = 0; j < 4; ++j) { const int c = 16 * mt + 4 * (lane >> 4) + j, jj = 16 * nt_ + (lane & 15); att[c * 72 + jj] = f2bf1(jj <= c ? acc[j] : 0.f); }
  }
  __syncthreads();
#pragma unroll
  for (int mt = 0; mt < 4; ++mt) {
    f32x4 acc = {0.f, 0.f, 0.f, 0.f};
    acc = mma_lds(acc, att + 16 * mt * 72, 72, vT + 16 * w * 72, 72, 64, lane);
    acc = mma_lds(acc, qe + 16 * mt * 72, 72, stT + 16 * w * 72, 72, 64, lane);
#pragma unroll
    for (int j = 0; j < 4; ++j) of[(16 * mt + 4 * (lane >> 4) + j) * 132 + 16 * w + (lane & 15)] = acc[j];
  }
  __syncthreads();
  { const int c = tid >> 3, e16 = (tid & 7) * 16; const float* onorm = IN_(21);
    float v[16]; float ss = 0.f;
#pragma unroll
    for (int j = 0; j < 16; ++j) { v[j] = of[c * 132 + e16 + j]; ss += v[j] * v[j]; }
    ss += shx(ss, 1); ss += shx(ss, 2); ss += shx(ss, 4);
    const float rs = __builtin_amdgcn_rsqf(ss * (1.f / 128.f) + EPS);
    f32x4 r0, r1, r2, r3;
    unpack8(*(const u32x4*)(Y + (size_t)(tok0 + c) * YLD + YC_GR + h * 128 + e16), r0, r1);
    unpack8(*(const u32x4*)(Y + (size_t)(tok0 + c) * YLD + YC_GR + h * 128 + e16 + 8), r2, r3);
    const float rr[16] = {r0[0], r0[1], r0[2], r0[3], r1[0], r1[1], r1[2], r1[3], r2[0], r2[1], r2[2], r2[3], r3[0], r3[1], r3[2], r3[3]};
#pragma unroll
    for (int j = 0; j < 16; ++j) v[j] = v[j] * rs * onorm[e16 + j] * siluf_(rr[j]);
    bf16_t* dst = mix + (size_t)(tok0 + c) * 1024 + 512 + h * 128 + e16;
    *(u32x4*)dst = (u32x4){pk2(v[0], v[1]), pk2(v[2], v[3]), pk2(v[4], v[5]), pk2(v[6], v[7])};
    *(u32x4*)(dst + 8) = (u32x4){pk2(v[8], v[9]), pk2(v[10], v[11]), pk2(v[12], v[13]), pk2(v[14], v[15])};
  }
  __syncthreads();
}

constexpr int AT_K = 0;
constexpr int AT_V = 13312;
constexpr int AT_BUF = 22528;
__device__ __forceinline__ void attn_pv(f32x16& o0, f32x16& o1, const bf16x8 (&pf)[4], const LAS bf16_t* Vs, int r, int hh) {
#pragma unroll
  for (int kb = 0; kb < 2; ++kb)
#pragma unroll
    for (int s2 = 0; s2 < 2; ++s2) {
      const int kofs = 32 * kb + 16 * s2 + 4 * hh;
      const u32x2 a00 = *(const LAS u32x2*)(Vs + r * 68 + kofs), a01 = *(const LAS u32x2*)(Vs + r * 68 + kofs + 8);
      const u32x2 a10 = *(const LAS u32x2*)(Vs + (32 + r) * 68 + kofs), a11 = *(const LAS u32x2*)(Vs + (32 + r) * 68 + kofs + 8);
      const u32x4 A0 = {a00[0], a00[1], a01[0], a01[1]}, A1 = {a10[0], a10[1], a11[0], a11[1]};
      o0 = __builtin_amdgcn_mfma_f32_32x32x16_bf16(__builtin_bit_cast(bf16x8, A0), pf[2 * kb + s2], o0, 0, 0, 0);
      o1 = __builtin_amdgcn_mfma_f32_32x32x16_bf16(__builtin_bit_cast(bf16x8, A1), pf[2 * kb + s2], o1, 0, 0, 0);
    }
}
__device__ __forceinline__ void attn_tile(int kt, const LAS bf16_t* Ks, const LAS bf16_t* Vs, const bf16x8 (&qf)[6], f32x16& o0, f32x16& o1, float& mrun, float& lrun, bf16x8 (&pf)[4], bool& pend,
                                          bool grpB, int qw0, int q, int r, int hh) {
  const int k0 = kt * 64;
  if (k0 > qw0 + 31) return;
  f32x16 s0, s1;
  { const f32x16 z16 = {0.f, 0.f, 0.f, 0.f, 0.f, 0.f, 0.f, 0.f, 0.f, 0.f, 0.f, 0.f, 0.f, 0.f, 0.f, 0.f};
    const bf16x8 ka = *(const LAS bf16x8*)(Ks + r * 104 + 8 * hh);
    const bf16x8 kb = *(const LAS bf16x8*)(Ks + (32 + r) * 104 + 8 * hh);
    s0 = __builtin_amdgcn_mfma_f32_32x32x16_bf16(ka, qf[0], z16, 0, 0, 0);
    s1 = __builtin_amdgcn_mfma_f32_32x32x16_bf16(kb, qf[0], z16, 0, 0, 0); }
#pragma unroll
  for (int ks = 1; ks < 6; ++ks) {
    const bf16x8 ka = *(const LAS bf16x8*)(Ks + r * 104 + 16 * ks + 8 * hh);
    const bf16x8 kb = *(const LAS bf16x8*)(Ks + (32 + r) * 104 + 16 * ks + 8 * hh);
    s0 = __builtin_amdgcn_mfma_f32_32x32x16_bf16(ka, qf[ks], s0, 0, 0, 0);
    s1 = __builtin_amdgcn_mfma_f32_32x32x16_bf16(kb, qf[ks], s1, 0, 0, 0);
  }
  if (k0 + 63 > qw0) {
#pragma unroll
    for (int i = 0; i < 16; ++i) { const int key = k0 + (i & 3) + 8 * (i >> 2) + 4 * hh; if (key > q) s0[i] = -1e30f; if (key + 32 > q) s1[i] = -1e30f; }
  }
  float tm = s0[0];
#pragma unroll
  for (int i = 1; i < 16; ++i) tm = fmaxf(tm, s0[i]);
#pragma unroll
  for (int i = 0; i < 16; ++i) tm = fmaxf(tm, s1[i]);
  tm = fmaxf(tm, shx(tm, 32));
  const float mnew = fmaxf(mrun, tm), alpha = __builtin_amdgcn_exp2f(mrun - mnew);
  const int mnew_changed = (mnew != mrun);
  mrun = mnew;
  f32x2_t ps2 = {0.f, 0.f}; const f32x2_t m2 = {mnew, mnew};
#pragma unroll
  for (int i = 0; i < 8; ++i) {
    f32x2_t a = (f32x2_t){s0[2 * i], s0[2 * i + 1]} - m2, b = (f32x2_t){s1[2 * i], s1[2 * i + 1]} - m2;
    a[0] = __builtin_amdgcn_exp2f(a[0]); a[1] = __builtin_amdgcn_exp2f(a[1]); b[0] = __builtin_amdgcn_exp2f(b[0]); b[1] = __builtin_amdgcn_exp2f(b[1]);
    ps2 += a; ps2 += b;
    s0[2 * i] = a[0]; s0[2 * i + 1] = a[1]; s1[2 * i] = b[0]; s1[2 * i + 1] = b[1];
  }
  lrun = lrun * alpha + (ps2[0] + ps2[1]);
  if (__any(mnew_changed)) {
#pragma unroll
    for (int i = 0; i < 16; ++i) { o0[i] *= alpha; o1[i] *= alpha; }
  }
#pragma unroll
  for (int s2 = 0; s2 < 2; ++s2) {
    const u32x4 w0 = {pk2(s0[8 * s2], s0[8 * s2 + 1]), pk2(s0[8 * s2 + 2], s0[8 * s2 + 3]), pk2(s0[8 * s2 + 4], s0[8 * s2 + 5]), pk2(s0[8 * s2 + 6], s0[8 * s2 + 7])};
    const u32x4 w1 = {pk2(s1[8 * s2], s1[8 * s2 + 1]), pk2(s1[8 * s2 + 2], s1[8 * s2 + 3]), pk2(s1[8 * s2 + 4], s1[8 * s2 + 5]), pk2(s1[8 * s2 + 6], s1[8 * s2 + 7])};
    pf[s2] = __builtin_bit_cast(bf16x8, w0); pf[2 + s2] = __builtin_bit_cast(bf16x8, w1);
  }
  if (grpB) pend = true; else attn_pv(o0, o1, pf, Vs, r, hh);
}

__device__ __forceinline__ void attn_unit(const Args& a, const Frame& F, int b, int h, int qb) {
  const bf16_t* Q = (const bf16_t*)(F.ws + WS_Q); const bf16_t* KV = (const bf16_t*)F.out; const bf16_t* KR = (const bf16_t*)(F.ws + WS_KR); bf16_t* mix = (bf16_t*)(F.ws + WS_HBB);
  const int tid = F.tid, lane = F.lane, w = F.wave, r = lane & 31, hh = lane >> 5;
  const size_t tb = (size_t)b * SEQ;
  const int qw0 = qb * 256 + w * 32, q = qw0 + r;
  bf16x8 qf[6];
#pragma unroll
  for (int ks = 0; ks < 6; ++ks) qf[ks] = *(const bf16x8*)(Q + (tb + q) * 768 + h * 96 + 16 * ks + 8 * hh);
  f32x16 o0, o1;
#pragma unroll
  for (int i = 0; i < 16; ++i) { o0[i] = 0.f; o1[i] = 0.f; }
  float mrun = -1e30f, lrun = 0.f;
  const int nkt = 4 * (qb + 1);
  const bool grpB = (w >= 4); bool pend = false;
  bf16x8 pf[4] = {};
  const int kp0 = tid, kp1 = tid + 512;
  const int kk0 = kp0 / 12, kpt0 = kp0 % 12, kk1 = kp1 / 12, kpt1 = kp1 % 12;
  const int vd = tid >> 3, vpart = tid & 7;
  const bf16_t* gk0 = (kpt0 < 8) ? KV + (tb + kk0) * 1024 + h * 128 + 8 * kpt0 : KR + (tb + kk0) * 32 + 8 * (kpt0 - 8); const size_t gs0 = (kpt0 < 8) ? 64 * 1024 : 64 * 32;
  const bf16_t* gk1 = (kpt1 < 8) ? KV + (tb + kk1) * 1024 + h * 128 + 8 * kpt1 : KR + (tb + kk1) * 32 + 8 * (kpt1 - 8); const size_t gs1 = (kpt1 < 8) ? 64 * 1024 : 64 * 32;
  const bf16_t* gv = KV + (size_t)T * 1024 + ((size_t)(b * 8 + h) * 64 + vd) * SEQ + 8 * vpart;
  u32x4 rk0[2], rk1[2] = {{0u, 0u, 0u, 0u}, {0u, 0u, 0u, 0u}}, rv[2];
#define AT_LOAD(S, kt) do { rk0[S] = *(const u32x4*)(gk0 + (size_t)(kt) * gs0); if (kp1 < 768) rk1[S] = *(const u32x4*)(gk1 + (size_t)(kt) * gs1); rv[S] = *(const u32x4*)(gv + (size_t)(kt) * 64); } while (0)
#define AT_TILE_OFF(t) ((((t) >> 1) & 1) * (2 * AT_BUF) + ((t) & 1) * AT_BUF)
#define AT_WRITE(S, kt) do { const int bo = AT_TILE_OFF(kt); \
    LAS bf16_t* Kw = (LAS bf16_t*)(F.lds + AT_K + bo); LAS bf16_t* Vw = (LAS bf16_t*)(F.lds + AT_V + bo); \
    *(LAS u32x4*)(Kw + kk0 * 104 + 8 * kpt0) = rk0[S]; \
    if (kp1 < 768) *(LAS u32x4*)(Kw + kk1 * 104 + 8 * kpt1) = rk1[S]; \
    *(LAS u32x2*)(Vw + vd * 68 + 8 * vpart) = (u32x2){rv[S][0], rv[S][1]}; *(LAS u32x2*)(Vw + vd * 68 + 8 * vpart + 4) = (u32x2){rv[S][2], rv[S][3]}; } while (0)
#define AT_COMPUTE(kt) do { const int bo = AT_TILE_OFF(kt); \
    if (pend) { attn_pv(o0, o1, pf, (const LAS bf16_t*)(F.lds + AT_V + AT_TILE_OFF((kt) - 1)), r, hh); pend = false; } \
    attn_tile((kt), (const LAS bf16_t*)(F.lds + AT_K + bo), (const LAS bf16_t*)(F.lds + AT_V + bo), qf, o0, o1, mrun, lrun, pf, pend, grpB, qw0, q, r, hh); } while (0)
  AT_LOAD(0, 0); AT_LOAD(1, 1);
  __syncthreads();
  AT_WRITE(0, 0); AT_WRITE(1, 1); AT_LOAD(0, 2); AT_LOAD(1, 3);
  for (int kt = 0; kt < nkt; kt += 2) {
    __syncthreads();
    if (kt + 2 < nkt) { AT_WRITE(0, kt + 2); AT_WRITE(1, kt + 3); if (kt + 4 < nkt) { AT_LOAD(0, kt + 4); AT_LOAD(1, kt + 5); } }
    AT_COMPUTE(kt); AT_COMPUTE(kt + 1);
    if (pend) { attn_pv(o0, o1, pf, (const LAS bf16_t*)(F.lds + AT_V + AT_TILE_OFF(kt + 1)), r, hh); pend = false; }
  }
#undef AT_COMPUTE
#undef AT_TILE_OFF
#undef AT_WRITE
#undef AT_LOAD
  const float lt = lrun + shx(lrun, 32), inv = __builtin_amdgcn_rcpf(lt);
  bf16_t* dst = mix + (tb + q) * 1024 + h * 64;
#pragma unroll
  for (int g4 = 0; g4 < 4; ++g4) {
    const int d = 8 * g4 + 4 * hh;
    *(u32x2*)(dst + d) = (u32x2){pk2(o0[4 * g4] * inv, o0[4 * g4 + 1] * inv), pk2(o0[4 * g4 + 2] * inv, o0[4 * g4 + 3] * inv)};
    *(u32x2*)(dst + 32 + d) = (u32x2){pk2(o1[4 * g4] * inv, o1[4 * g4 + 1] * inv), pk2(o1[4 * g4 + 2] * inv, o1[4 * g4 + 3] * inv)};
  }
}

#define PH(k) if (lo <= (k) && (k) < hi)
#define SYNC(k) do { if (lo <= (k) && (k) + 1 < hi) { xcd_barrier(F.xb); } } while (0)
#define WPTR(off) ((const bf16_t*)(F.ws + WS_W + (off)))
#define GTID (F.bid * NTHR + F.tid)
#define GTHREADS (F.G * NTHR)


__device__ __forceinline__ void even_mixer_phases(const Args& a, const Frame& F, int lo, int hi) {
  bf16_t* const hbA = (bf16_t*)(F.ws + WS_HBA); bf16_t* const hbB = (bf16_t*)(F.ws + WS_HBB);
  bf16_t* const Y = (bf16_t*)(F.ws + WS_Y);
  PH(3) { if (F.G >= 160 && F.bid >= 128 && F.bid < 160) s5_group_item(a, F, F.bid - 128);
    EpiWinEven E{Y, statp(F, 1), statp(F, 9), statp(F, 10)}; run_gemm<T, 2304, 1024, 1024>(F, hbA, WPTR(WO_WINE), E); } SYNC(3);
  PH(4) {
    { EpiQ E{(bf16_t*)(F.ws + WS_Q), statp(F, 9), (const float*)(F.ws + WS_ROPE)}; run_gemm<T, 768, 384, YLD>(F, Y, WPTR(WO_WQ), E); }
    { EpiKV E{(bf16_t*)F.out, (bf16_t*)F.out + (size_t)T * 1024, statp(F, 10)}; run_gemm<T, 1024, 256, YLD>(F, Y + 384, WPTR(WO_WKV), E, F.G, (F.bid + 128) % F.G); }
    { const float* rope = (const float*)(F.ws + WS_ROPE); bf16_t* KR = (bf16_t*)(F.ws + WS_KR);
      for (int t = GTID; t < T; t += GTHREADS) {
        const int pos = t & (SEQ - 1);
#pragma unroll
        for (int i = 0; i < 2; ++i) {
          f32x4 a0, a1, b0, b1; unpack8(*(const u32x4*)(Y + (size_t)t * YLD + YC_KR + 8 * i), a0, a1); unpack8(*(const u32x4*)(Y + (size_t)t * YLD + YC_KR + 16 + 8 * i), b0, b1);
          f32x4 x0, x1, y0, y1;
#pragma unroll
          for (int j = 0; j < 4; ++j) {
            const float c0 = rope[(pos * 16 + 8 * i + j) * 2], s0 = rope[(pos * 16 + 8 * i + j) * 2 + 1], c1 = rope[(pos * 16 + 8 * i + 4 + j) * 2], s1 = rope[(pos * 16 + 8 * i + 4 + j) * 2 + 1];
            x0[j] = a0[j] * c0 - b0[j] * s0; y0[j] = a0[j] * s0 + b0[j] * c0; x1[j] = a1[j] * c1 - b1[j] * s1; y1[j] = a1[j] * s1 + b1[j] * c1; }
          *(u32x4*)(KR + (size_t)t * 32 + 8 * i) = pack8(x0, x1); *(u32x4*)(KR + (size_t)t * 32 + 16 + 8 * i) = pack8(y0, y1);
        }
      } }
    for (int it = F.bid; it < 2048; it += F.G) gla_part1(a, F, it);
  } SYNC(4);
  PH(5) { gla_scan(a, F); } SYNC(5);
  PH(6) {
    for (int c = F.bid; c < 256; c += F.G) {
      const int bh = c & 31, j = c >> 5, b = bh >> 3, h = bh & 7;
      for (int u4 = 0; u4 < 4; ++u4) { const int qb = (u4 == 0) ? 31 - j : (u4 == 1) ? 16 + j : (u4 == 2) ? 15 - j : j; attn_unit(a, F, b, h, qb); }
    }
    __syncthreads();
    for (int it = F.bid; it < 2048; it += F.G) gla_part3(a, F, it);
  } SYNC(6);
  PH(7) { EpiResid<0> E{nullptr, hbA, nullptr, hbA, statp(F, 2), 1.f, nullptr, nullptr}; run_gemm<T, 1024, 1024, 1024>(F, hbB, WPTR(WO_WOUTE), E); } SYNC(7);
}

__device__ __forceinline__ void odd_mixer_phases(const Args& a, const Frame& F, int lo, int hi) {
  bf16_t* const hbA = (bf16_t*)(F.ws + WS_HBA); bf16_t* const hbB = (bf16_t*)(F.ws + WS_HBB);
  bf16_t* const Yo = (bf16_t*)(F.ws + WS_YO); bf16_t* const Upk = (bf16_t*)(F.ws + WS_UPK); bf16_t* const xc = (bf16_t*)(F.ws + WS_XC);
  bf16_t* const yg = (bf16_t*)(F.ws + WS_YG); bf16_t* const la = (bf16_t*)F.out; bf16_t* const bx = (bf16_t*)F.out + (size_t)T * 512;
  PH(13) { EpiWinOdd E{Yo, Upk, statp(F, 5)}; run_gemm<T, 1536, 1024, 1024>(F, hbA, WPTR(WO_WINO), E); } SYNC(13);
  PH(14) {
    { const float* cw = IN_(24); const float* cb = IN_(25);
      for (int it0 = GTID; it0 < T * 64; it0 += 4 * GTHREADS) {
        u32x4 raw[4][4];
#pragma unroll
        for (int q = 0; q < 4; ++q) { const int it = it0 + q * GTHREADS; const int t = it >> 6, c8 = (it & 63) * 8, pos = t & (SEQ - 1);
#pragma unroll
          for (int k = 0; k < 4; ++k) raw[q][k] = (it < T * 64 && pos - 3 + k >= 0) ? *(const u32x4*)(Yo + (size_t)(t - 3 + k) * 1024 + 512 + c8) : (u32x4){0u, 0u, 0u, 0u}; }
#pragma unroll
        for (int q = 0; q < 4; ++q) { const int it = it0 + q * GTHREADS; if (it < T * 64) { const int t = it >> 6, c8 = (it & 63) * 8;
          f32x4 s0 = *(const f32x4*)(cb + c8), s1 = *(const f32x4*)(cb + c8 + 4);
#pragma unroll
          for (int k = 0; k < 4; ++k) { f32x4 v0, v1; unpack8(raw[q][k], v0, v1); s0 += *(const f32x4*)(cw + k * 512 + c8) * v0; s1 += *(const f32x4*)(cw + k * 512 + c8 + 4) * v1; }
          *(u32x4*)(xc + (size_t)t * 512 + c8) = pack8(s0, s1); } }
      } }
    { EpiZ E{(float*)(F.ws + WS_Z)}; run_gemm<1024, 256, 512, 640, 32, (size_t)1024 * 640 * 2, (size_t)256 * 512 * 2>(F, Upk, WPTR(WO_WZ), E); }
  } SYNC(14);
  PH(15) {
    const int nscan = (F.G >= 64) ? 16 : 0;
    if (F.bid < nscan || nscan == 0) {
      const float* AL = (const float*)(F.ws + WS_AL); const float* Z = (const float*)(F.ws + WS_Z);
      const int nthr_s = (nscan ? nscan : F.G) * NTHR;
      for (int gid = GTID; gid < 8192; gid += nthr_s) {
        const int b = gid >> 11, g = (gid >> 6) & 31, p = gid & 63;
        const float ar = AL[(g * 64 + p) * 2], ai_ = AL[(g * 64 + p) * 2 + 1];
        float xr = 0.f, xi = 0.f;
        for (int ch = 0; ch < 256; ch += 16) {
          float zr[16], zi[16];
#pragma unroll
          for (int i = 0; i < 16; ++i) { const size_t zo = ((size_t)(b * 256 + ch + i) * 32 + g) * 128 + p; zr[i] = Z[zo]; zi[i] = Z[zo + 64]; }
#pragma unroll
          for (int i = 0; i < 16; ++i) { bf16_t* up = Upk + ((size_t)g * 1024 + b * 256 + ch + i) * 640 + 512 + p; up[0] = f2bf1(xr); up[64] = f2bf1(xi);
            const float nr = ar * xr - ai_ * xi + zr[i], ni = ar * xi + ai_ * xr + zi[i]; xr = nr; xi = ni; }
        }
      }
    }
    { EpiRG E{la, bx, xc, IN_(27), IN_(29), (const float*)(F.ws + WS_C8SP)};
      if (nscan) run_gemm<T, 1024, 512, 512>(F, xc, WPTR(WO_WRG), E, F.G - nscan, F.bid >= nscan ? F.bid - nscan : -1);
      else run_gemm<T, 1024, 512, 512>(F, xc, WPTR(WO_WRG), E); }
  } SYNC(15);
  PH(16) {
    { float* Aprod = (float*)(F.ws + WS_APROD); float* Hend = (float*)(F.ws + WS_HEND);
      for (int gid = GTID; gid < 512 * 256; gid += GTHREADS) {
        const int chunk = gid >> 8, cp = gid & 255; const size_t base = (size_t)chunk * 64 * 512 + 2 * cp;
        float S0 = 0.f, S1 = 0.f, h0 = 0.f, h1 = 0.f;
        for (int t0 = 0; t0 < 64; t0 += 16) {
          unsigned wl[16], wb[16];
#pragma unroll
          for (int i = 0; i < 16; ++i) { wl[i] = *(const unsigned*)(la + base + (size_t)(t0 + i) * 512); wb[i] = *(const unsigned*)(bx + base + (size_t)(t0 + i) * 512); }
#pragma unroll
          for (int i = 0; i < 16; ++i) { const float l0 = bf_lo(wl[i]), l1 = bf_hi(wl[i]); S0 += l0; S1 += l1; h0 = fexp(l0) * h0 + bf_lo(wb[i]); h1 = fexp(l1) * h1 + bf_hi(wb[i]); }
        }
        Aprod[chunk * 512 + 2 * cp] = fexp(S0); Aprod[chunk * 512 + 2 * cp + 1] = fexp(S1); Hend[chunk * 512 + 2 * cp] = h0; Hend[chunk * 512 + 2 * cp + 1] = h1;
      } }
    { EpiS5Y E{yg, Upk, IN_(38)}; run_gemm<1024, 512, 640, 640, 32, (size_t)1024 * 640 * 2, (size_t)512 * 640 * 2>(F, Upk, WPTR(WO_MW), E); }
  } SYNC(16);
  PH(17) {
    { const float* Aprod = (const float*)(F.ws + WS_APROD); const float* Hend = (const float*)(F.ws + WS_HEND);
      for (int gid = GTID; gid < 512 * 256; gid += GTHREADS) {
        const int chunk = gid >> 8, cp = gid & 255, nb = chunk & 127; const size_t base = (size_t)chunk * 64 * 512 + 2 * cp;
        float h0 = 0.f, h1 = 0.f;
        { int m = chunk - nb;
          for (; m + 8 <= chunk; m += 8) {
            f32x2_t A2[8], H2[8];
#pragma unroll
            for (int i = 0; i < 8; ++i) { A2[i] = *(const f32x2_t*)(Aprod + (m + i) * 512 + 2 * cp); H2[i] = *(const f32x2_t*)(Hend + (m + i) * 512 + 2 * cp); }
#pragma unroll
            for (int i = 0; i < 8; ++i) { h0 = A2[i][0] * h0 + H2[i][0]; h1 = A2[i][1] * h1 + H2[i][1]; }
          }
          for (; m < chunk; ++m) { const f32x2_t A2 = *(const f32x2_t*)(Aprod + m * 512 + 2 * cp), H2 = *(const f32x2_t*)(Hend + m * 512 + 2 * cp); h0 = A2[0] * h0 + H2[0]; h1 = A2[1] * h1 + H2[1]; } }
        for (int t0 = 0; t0 < 64; t0 += 8) {
          unsigned wl[8], wb[8], wg[8], wo[8];
#pragma unroll
          for (int i = 0; i < 8; ++i) { wl[i] = *(const unsigned*)(la + base + (size_t)(t0 + i) * 512); wb[i] = *(const unsigned*)(bx + base + (size_t)(t0 + i) * 512); wg[i] = *(const unsigned*)(Yo + ((size_t)chunk * 64 + t0 + i) * 1024 + 2 * cp); }
#pragma unroll
          for (int i = 0; i < 8; ++i) { h0 = fexp(bf_lo(wl[i])) * h0 + bf_lo(wb[i]); h1 = fexp(bf_hi(wl[i])) * h1 + bf_hi(wb[i]); wo[i] = pk2(h0 * geluf_(bf_lo(wg[i])), h1 * geluf_(bf_hi(wg[i]))); }
#pragma unroll
          for (int i = 0; i < 8; ++i) *(unsigned*)(hbB + ((size_t)chunk * 64 + t0 + i) * 1024 + 2 * cp) = wo[i];
        }
      } }
    { EpiGLU E{hbB, yg, IN_(40)}; run_gemm<T, 512, 512, 512>(F, yg, WPTR(WO_WGLU), E); }
  } SYNC(17);
  PH(18) { EpiResid<0> E{nullptr, hbA, nullptr, hbA, statp(F, 6), 1.f, nullptr, nullptr}; run_gemm<T, 1024, 1024, 1024>(F, hbB, WPTR(WO_WOUTO), E); } SYNC(18);
}

template <int L> __device__ __forceinline__ void layer_phases(const Args& a, const Frame& F, int lo, int hi) {
  constexpr int pb0 = 1 + 10 * L, st0 = 4 * L, pn_ = L ? 19 : 8;
  bf16_t* const hbA = (bf16_t*)(F.ws + WS_HBA); bf16_t* const hbB = (bf16_t*)(F.ws + WS_HBB); bf16_t* const Gb = (bf16_t*)(F.ws + WS_G);
  PH(pb0) { EpiSwiglu E{Gb, statp(F, st0)}; run_gemm<T, 5632, 1024, 1024>(F, hbB, WPTR(WO_W13 + (size_t)(L * 2) * W13_B), E); } SYNC(pb0);
  PH(pb0 + 1) { EpiResid<0> E{nullptr, hbB, nullptr, hbA, statp(F, st0 + 1), 0.5f, nullptr, nullptr}; run_gemm<T, 1024, FF, FF>(F, Gb, WPTR(WO_W2 + (size_t)(L * 2) * W2_B), E); } SYNC(pb0 + 1);
  if (L == 0) even_mixer_phases(a, F, lo, hi); else odd_mixer_phases(a, F, lo, hi);
  PH(pn_) { EpiSwiglu E{Gb, statp(F, st0 + 2)}; run_gemm<T, 5632, 1024, 1024>(F, hbA, WPTR(WO_W13 + (size_t)(L * 2 + 1) * W13_B), E); } SYNC(pn_);
  PH(pn_ + 1) { EpiResid<0> E{nullptr, hbA, nullptr, hbA, statp(F, st0 + 3), 0.5f, nullptr, nullptr}; run_gemm<T, 1024, FF, FF>(F, Gb, WPTR(WO_W2 + (size_t)(L * 2 + 1) * W2_B), E); } SYNC(pn_ + 1);
  PH(pn_ + 2) {
    bf16_t* U = (bf16_t*)(F.ws + WS_U);
    { EpiStore E{U, 1024, nullptr, 0.f}; run_gemm<T, 1024, 256, 256>(F, (const bf16_t*)(F.ws + WS_PB) + (size_t)L * T * 256, WPTR(WO_WUP + (size_t)L * 1024 * 256 * 2), E); }
    { EpiResid<1> E{nullptr, hbA, nullptr, hbB, statp(F, st0 + 4), 0.f, U, statp(F, st0 + 3)}; run_gemm<T, 1024, 1024, 1024>(F, hbA, WPTR(WO_WG + (size_t)L * 1024 * 1024 * 2), E); }
  } SYNC(pn_ + 2);
}

__global__ void __launch_bounds__(NTHR, 2) mega_fwd(Args a) {
  extern __shared__ __attribute__((aligned(16))) uchar lds_raw[];
  Frame F;
  F.lds = (LAS uchar*)lds_raw; F.tid = threadIdx.x; F.lane = F.tid & 63; F.wave = __builtin_amdgcn_readfirstlane(F.tid >> 6);
  F.bid = blockIdx.x; F.G = gridDim.x; F.ws = a.ws; F.out = a.out; F.stat = (sq_t*)(a.ws + WS_STAT);
  const int lo = a.ph_lo, hi = a.ph_hi;
  { volatile LAS unsigned* st = (volatile LAS unsigned*)(F.lds + XB_LDS_OFF);
    if (F.tid < 2) st[F.tid] = 0u;
    __syncthreads();
    F.xb.bar = (unsigned*)(a.ws + WS_XBAR); F.xb.x = 0; F.xb.st = st;
    if (hi - lo > 1) F.xb = xcd_barrier_post((unsigned*)(a.ws + WS_XBAR), st); }
  if (lo < 0) cg::this_grid().sync();
  PH(0) { p0_prologue(a, F); } SYNC(0);
  layer_phases<0>(a, F, lo, hi);
  layer_phases<1>(a, F, lo, hi);
  PH(22) {
    const sq_t* sq = statp(F, 8); const float* gn = IN_(42); const bf16_t* hb = (const bf16_t*)(a.ws + WS_HBB);
    const int gw = F.bid * 8 + F.wave, nw = F.G * 8;
    for (int row = gw; row < T; row += nw) {
      const float rs = rs_of(sq[row], 1.f / 1024.f);
#pragma unroll
      for (int i = 0; i < 2; ++i) { const int c8 = (F.lane + 64 * i) * 8; f32x4 v0, v1; unpack8(*(const u32x4*)(hb + (size_t)row * DM + c8), v0, v1);
        const f32x4 g0 = *(const f32x4*)(gn + c8), g1 = *(const f32x4*)(gn + c8 + 4);
        *(f32x4*)(F.out + (size_t)row * DM + c8) = v0 * rs * g0; *(f32x4*)(F.out + (size_t)row * DM + c8 + 4) = v1 * rs * g1; }
    }
  }
}
#undef PH
#undef SYNC

extern "C" void kernel_launch(void* const* d_in, const int* in_sizes, int n_in, void* d_out, int out_size, void* d_ws, size_t ws_size, hipStream_t stream) {
  static int grid = 0;
  if (grid == 0) {
    if (n_in != 43 || out_size != T * DM || ws_size < WS_END) { fprintf(stderr, "kernel_launch: unexpected shapes (n_in %d out %d ws %zu)\n", n_in, out_size, ws_size); grid = -1; return; }
    int dev = 0, cus = 0, per_cu = 0;
    hipGetDevice(&dev); hipDeviceGetAttribute(&cus, hipDeviceAttributeMultiprocessorCount, dev);
    if (hipFuncSetAttribute((const void*)mega_fwd, hipFuncAttributeMaxDynamicSharedMemorySize, LDS_BYTES) != hipSuccess) { fprintf(stderr, "kernel_launch: hipFuncSetAttribute failed\n"); grid = -1; return; }
    if (hipOccupancyMaxActiveBlocksPerMultiprocessor(&per_cu, (const void*)mega_fwd, NTHR, LDS_BYTES) != hipSuccess || per_cu < 1) { fprintf(stderr, "kernel_launch: occupancy query gave %d\n", per_cu); per_cu = 1; }
    (void)hipGetLastError();
    grid = cus * 1;
    fprintf(stderr, "kernel_launch: grid %d (cus %d, per_cu %d)\n", grid, cus, per_cu);
  }
  if (grid < 0) return;
  hipMemsetAsync((char*)d_ws + WS_STAT, 0, STAT_ZERO_BYTES, stream);
  Args a{};
  for (int i = 0; i < 43; ++i) a.in[i] = (const float*)d_in[i];
  a.out = (float*)d_out; a.ws = (uchar*)d_ws;
#if MK_PER_PHASE_LAUNCH
  for (int ph = 0; ph < NPHASE; ++ph) { a.ph_lo = ph; a.ph_hi = ph + 1;
    for (int rep = 0; rep < 1 + (int)((REPEAT_MASK >> ph) & 1u); ++rep) hipLaunchKernelGGL(mega_fwd, dim3(grid), dim3(NTHR), LDS_BYTES, stream, a); }
#else
  a.ph_lo = 0; a.ph_hi = NPHASE;
  void* args[] = {&a};
  hipError_t e = hipLaunchCooperativeKernel((const void*)mega_fwd, dim3(grid), dim3(NTHR), args, LDS_BYTES, stream);
  if (e != hipSuccess) fprintf(stderr, "cooperative launch failed: %s (grid %d)\n", hipGetErrorString(e), grid);
#endif
}
```

```cpp
#include <hip/hip_runtime.h>
#include <hip/hip_cooperative_groups.h>
#include <cstdio>
#include <cstdint>
namespace cg = cooperative_groups;

#ifndef REPEAT_MASK
#define REPEAT_MASK 0u
#endif
#ifndef MK_PER_PHASE_LAUNCH
#define MK_PER_PHASE_LAUNCH 0
#endif

#define LAS __attribute__((address_space(3)))
typedef unsigned short bf16_t;
typedef unsigned char uchar;
typedef short bf16x8 __attribute__((ext_vector_type(8)));
typedef short s16x4 __attribute__((ext_vector_type(4)));
typedef float f32x4 __attribute__((ext_vector_type(4)));
typedef float f32x16 __attribute__((ext_vector_type(16)));
typedef unsigned u32x4 __attribute__((ext_vector_type(4)));
typedef unsigned u32x2 __attribute__((ext_vector_type(2)));
typedef float f32x2_t __attribute__((ext_vector_type(2)));
typedef __bf16 bf16x2_t __attribute__((ext_vector_type(2)));

constexpr int T = 32768, SEQ = 8192, DM = 1024, FF = 2816;
constexpr float EPS = 1e-6f;
constexpr int NPHASE = 23;
constexpr int NTHR = 512;

constexpr size_t MiB = 1u << 20;
constexpr size_t WS_STAT = 0;
constexpr size_t STAT_ZERO_BYTES = 3 * MiB;
constexpr size_t WS_XBAR = 3 * MiB - 64 * 1024;
constexpr size_t WS_ROPE = 4 * MiB;
constexpr size_t WS_AL = 5 * MiB;
constexpr size_t WS_C8SP = 5 * MiB + 64 * 1024;
constexpr size_t WS_DECAY = 6 * MiB;
constexpr size_t WS_APROD = 7 * MiB;
constexpr size_t WS_HEND = 8 * MiB;
constexpr size_t WS_W = 10 * MiB;
constexpr size_t W13_B = (size_t)5632 * 1024 * 2, W2_B = (size_t)1024 * 2816 * 2;
constexpr size_t WO_W13 = 0;
constexpr size_t WO_W2 = WO_W13 + 4 * W13_B;
constexpr size_t WO_WG = WO_W2 + 4 * W2_B;
constexpr size_t WO_WUP = WO_WG + 2 * (size_t)1024 * 1024 * 2;
constexpr size_t WO_WINE = WO_WUP + 2 * (size_t)1024 * 256 * 2;
constexpr size_t WO_WQ = WO_WINE + (size_t)2304 * 1024 * 2;
constexpr size_t WO_WKV = WO_WQ + (size_t)768 * 384 * 2;
constexpr size_t WO_WOUTE = WO_WKV + (size_t)1024 * 256 * 2;
constexpr size_t WO_WINO = WO_WOUTE + (size_t)1024 * 1024 * 2;
constexpr size_t WO_WRG = WO_WINO + (size_t)1536 * 1024 * 2;
constexpr size_t WO_WGLU = WO_WRG + (size_t)1024 * 512 * 2;
constexpr size_t WO_WOUTO = WO_WGLU + (size_t)512 * 512 * 2;
constexpr size_t WO_MW = WO_WOUTO + (size_t)1024 * 1024 * 2;
constexpr size_t WO_WZ = WO_MW + (size_t)32 * 512 * 640 * 2;
constexpr size_t WO_END = WO_WZ + (size_t)32 * 256 * 512 * 2;
static_assert(WS_W + WO_END <= 124 * MiB, "weights region");
constexpr size_t WS_HBA = 124 * MiB;
constexpr size_t WS_HBB = 188 * MiB;
constexpr size_t WS_PB = 252 * MiB;
constexpr size_t WS_R = 284 * MiB;
constexpr size_t WS_G = WS_R;
constexpr size_t WS_U = WS_R;
constexpr size_t WS_Y = WS_R;
constexpr size_t WS_Q = WS_R + 144 * MiB;
constexpr size_t WS_KR = WS_R + 192 * MiB;
constexpr size_t WS_CKV = WS_R + 194 * MiB;
constexpr size_t WS_YO = WS_R;
constexpr size_t WS_UPK = WS_R + 64 * MiB;
constexpr size_t WS_XC = WS_R + 104 * MiB;
constexpr size_t WS_Z = WS_R + 136 * MiB;
constexpr size_t WS_YG = WS_R + 152 * MiB;
constexpr size_t WS_END = 512 * MiB;
static_assert(WS_CKV + 32 * MiB <= WS_END && WS_YG + 32 * MiB <= WS_END, "ws map");

constexpr int XB_LDS_OFF = 131072 + 2048;
constexpr int LDS_BYTES = 135168;

constexpr int YC_GQ = 640, YC_GK = 896, YC_GV = 1152, YC_GR = 1664, YC_KR = 2176, YC_GLOW = 2208, YLD = 2304;

struct Args { const float* in[43]; float* out; uchar* ws; int ph_lo, ph_hi; };
typedef const __attribute__((address_space(4))) uchar* kaptr_t;
__device__ __forceinline__ kaptr_t ka_base() { kaptr_t p = (kaptr_t)__builtin_amdgcn_kernarg_segment_ptr(); asm volatile("" : "+s"(p)); return p; }
#define IN_(i) (*(const float* const __attribute__((address_space(4)))*)(ka_base() + 8 * (i)))

__device__ __forceinline__ unsigned pk2(float lo, float hi) { f32x2_t v = {lo, hi}; bf16x2_t b = __builtin_convertvector(v, bf16x2_t); return __builtin_bit_cast(unsigned, b); }
__device__ __forceinline__ float bf_lo(unsigned w) { return __uint_as_float(w << 16); }
__device__ __forceinline__ float bf_hi(unsigned w) { return __uint_as_float(w & 0xffff0000u); }
__device__ __forceinline__ float bf1(bf16_t v) { return __uint_as_float(((unsigned)v) << 16); }
__device__ __forceinline__ bf16_t f2bf1(float f) { return (bf16_t)(pk2(f, 0.f) & 0xffffu); }
__device__ __forceinline__ u32x4 pack8(f32x4 a, f32x4 b) { return (u32x4){pk2(a[0], a[1]), pk2(a[2], a[3]), pk2(b[0], b[1]), pk2(b[2], b[3])}; }
__device__ __forceinline__ void unpack8(u32x4 w, f32x4& a, f32x4& b) { a = (f32x4){bf_lo(w[0]), bf_hi(w[0]), bf_lo(w[1]), bf_hi(w[1])}; b = (f32x4){bf_lo(w[2]), bf_hi(w[2]), bf_lo(w[3]), bf_hi(w[3])}; }
__device__ __forceinline__ float fexp(float x) { return __builtin_amdgcn_exp2f(x * 1.4426950408889634f); }
__device__ __forceinline__ float sigmoidf_(float x) { return __builtin_amdgcn_rcpf(1.f + __builtin_amdgcn_exp2f(x * -1.4426950408889634f)); }
__device__ __forceinline__ float one_minus_exp(float x) {
  const float ser = -x * (1.f + x * (0.5f + x * (1.f / 6.f + x * (1.f / 24.f))));
  return x > -0.05f ? ser : 1.f - fexp(x);
}
__device__ __forceinline__ float siluf_(float x) { return x * sigmoidf_(x); }
__device__ __forceinline__ float geluf_(float x) { return x * sigmoidf_(1.5957691216057308f * (x + 0.044715f * x * x * x)); }
typedef unsigned long long sq_t;
__device__ __forceinline__ float rs_of(sq_t sumsq, float inv_n) { return __builtin_amdgcn_rsqf((float)sumsq * (1.f / 16777216.f) * inv_n + EPS); }
__device__ __forceinline__ void sq_add(sq_t* p, float part) { atomicAdd(p, (sq_t)(part * 16777216.f + 0.5f)); }
__device__ __forceinline__ float shx(float v, int m) { return __shfl_xor(v, m, 64); }
__device__ __forceinline__ void sincos_acc(double x, double& s, double& c) {
  const double k = rint(x * 0.63661977236758134308);
  const double r = fma(-k, 1.57079632679489655800, x) - k * 6.12323399573676603587e-17;
  const double r2 = r * r;
  double sp = r * (1.0 + r2 * (-1.0 / 6 + r2 * (1.0 / 120 + r2 * (-1.0 / 5040 + r2 * (1.0 / 362880 + r2 * (-1.0 / 39916800 + r2 * (1.0 / 6227020800.0)))))));
  double cp = 1.0 + r2 * (-0.5 + r2 * (1.0 / 24 + r2 * (-1.0 / 720 + r2 * (1.0 / 40320 + r2 * (-1.0 / 3628800 + r2 * (1.0 / 479001600.0 + r2 * (-1.0 / 87178291200.0)))))));
  const int q = ((int)(long long)k) & 3;
  if (q == 0) { s = sp; c = cp; } else if (q == 1) { s = cp; c = -sp; } else if (q == 2) { s = -sp; c = -cp; } else { s = -cp; c = sp; }
}

namespace pg8 {
constexpr int BM = 256, BK = 64, HALF = 128, HTB = HALF * BK * 2, STAGE_BYTES = 8 * HTB, NXCD = 8, WGM = 8;
__host__ __device__ __forceinline__ int lds_byte(int r, int c) { const int st = (r >> 4) * 2 + (c >> 5), rr = r & 15, cc = c & 31, ob = rr * 64 + cc * 2; return st * 1024 + (ob ^ (((ob >> 9) & 1) << 5)); }
__host__ __device__ __forceinline__ void stage_rc(int b, int& R, int& C) { const int st = b / 1024, sb = b % 1024, swz = sb ^ (((sb >> 9) & 1) << 5); R = (st >> 1) * 16 + swz / 64; C = (st & 1) * 32 + (swz % 64) / 2; }
__host__ __device__ __forceinline__ int perm32(int rho) { const int n = rho >> 4, i = rho & 15; return 8 * (i >> 2) + 4 * n + (i & 3); }

struct Unit { int pm, pn, z; };
struct Gemm { const bf16_t* A; const bf16_t* Bt; };
template <int M_, int N_, int NZ_> struct Order {
  static constexpr int nM = M_ / BM, nN = N_ / BM, per = nM * nN, nz = NZ_, nwg = per * NZ_;
  int G, c;
  __device__ __forceinline__ void init(int G_, int c_) { G = G_; c = c_; }
  __device__ __forceinline__ bool next(int i, Unit& u) const {
    if (c < 0) return false;
    const long L = (long)i * G + c; if (L >= nwg) return false;
    int wgid = (int)L;
    if (nz == 1) {
      { const int q = nwg / NXCD, r = nwg % NXCD, xcd = wgid % NXCD, off = wgid / NXCD; wgid = (xcd < r ? xcd * (q + 1) : r * (q + 1) + (xcd - r) * q) + off; }
      const int nig = WGM * nN, gid = wgid / nig, fm = gid * WGM, gsz = (nM - fm) < WGM ? (nM - fm) : WGM;
      u.pm = fm + ((wgid % nig) % gsz); u.pn = (wgid % nig) / gsz; u.z = 0;
    } else { u.z = wgid / per; const int r = wgid % per; u.pm = r % nM; u.pn = r / nM; }
    return true;
  }
};

template <class Epi, int M_, int N_, int K_, int LDA_, int NZ_, size_t SA_, size_t SB_>
__device__ __forceinline__ void gemm_phase(LAS uchar* lds, const Gemm g, const Order<M_, N_, NZ_>& S, const Epi& E) {
  const int tid = threadIdx.x, wid = __builtin_amdgcn_readfirstlane(tid >> 6), lane = tid & 63, wr = wid >> 2, wc = wid & 3, fr = lane & 15, fq = lane >> 4;
  constexpr int K = K_, nt = K / BK;
  static_assert(M_ % 256 == 0 && N_ % 256 == 0 && K_ % 128 == 0 && K_ >= 256, "gemm shape");
  unsigned voffA[2], voffB[2];
#pragma unroll
  for (int i = 0; i < 2; ++i) { int R, C; stage_rc(tid * 16 + i * 8192, R, C); const int Rb = (R & ~31) + perm32(R & 31);
    voffA[i] = (unsigned)(R * LDA_ + C) * 2u; voffB[i] = (unsigned)(Rb * K + C) * 2u; }
  size_t kstep = (size_t)(BK * 2), hstepA = (size_t)HALF * LDA_ * 2, hstepB = (size_t)HALF * K * 2;
  asm volatile("" : "+s"(kstep), "+s"(hstepA), "+s"(hstepB));
  constexpr size_t tstepA = 2 * (size_t)HALF * LDA_ * 2, tstepB = 2 * (size_t)HALF * K * 2;
  const unsigned ldsw = (unsigned)wid * 1024u;
  const int aoff = lds_byte(wr * 64 + fr, fq * 8), boff = lds_byte(wc * 32 + fr, fq * 8);
#define PG8_SA(b, h) (((b) * 2 + (h)) * HTB)
#define PG8_SB(b, h) ((4 + (b) * 2 + (h)) * HTB)
#define PG8_STAGE(bufoff, gbase, voff) do { _Pragma("unroll") for (int _i = 0; _i < 2; ++_i) \
    __builtin_amdgcn_global_load_lds((const unsigned*)((const char*)(gbase) + (voff)[_i]), (LAS unsigned*)(lds + (bufoff) + ldsw + _i * 8192), 16, 0, 0); } while (0)
#define PG8_LDA(dst, b, h) do { _Pragma("unroll") for (int m = 0; m < 4; ++m) _Pragma("unroll") for (int k = 0; k < 2; ++k) dst[m][k] = *(const LAS bf16x8*)(lds + PG8_SA(b, h) + aoff + m * 2048 + k * 1024); } while (0)
#define PG8_LDB(dst, b, h) do { _Pragma("unroll") for (int n = 0; n < 2; ++n) _Pragma("unroll") for (int k = 0; k < 2; ++k) dst[n][k] = *(const LAS bf16x8*)(lds + PG8_SB(b, h) + boff + n * 2048 + k * 1024); } while (0)
#define PG8_MMA(ai, bj, At, Bt) do { __builtin_amdgcn_s_setprio(1); _Pragma("unroll") for (int m = 0; m < 4; ++m) _Pragma("unroll") for (int n = 0; n < 2; ++n) _Pragma("unroll") for (int k = 0; k < 2; ++k) \
    acc[ai][bj][m][n] = __builtin_amdgcn_mfma_f32_16x16x32_bf16(Bt[n][k], At[m][k], acc[ai][bj][m][n], 0, 0, 0); __builtin_amdgcn_s_setprio(0); } while (0)
#define PG8_WAIT_V(n) asm volatile("s_waitcnt vmcnt(" #n ")" ::: "memory")
#define PG8_WAIT_L(n) asm volatile("s_waitcnt lgkmcnt(" #n ")" ::: "memory")
#define PG8_BAR __builtin_amdgcn_s_barrier()
#define PG8_SCHED __builtin_amdgcn_sched_barrier(0)
  Unit cur, nxt; int ui = 0;
  if (!S.next(0, cur)) return;
  f32x4 acc[2][2][4][2];
#pragma unroll
  for (int a = 0; a < 2; ++a)
#pragma unroll
    for (int b = 0; b < 2; ++b)
#pragma unroll
      for (int m = 0; m < 4; ++m)
#pragma unroll
        for (int n = 0; n < 2; ++n) acc[a][b][m][n] = (f32x4){0.f, 0.f, 0.f, 0.f};
  bf16x8 At[4][2], B0[2][2], B1[2][2];
  const char* cA = (const char*)g.A + (size_t)cur.z * SA_ + (size_t)cur.pm * tstepA;
  const char* cB = (const char*)g.Bt + (size_t)cur.z * SB_ + (size_t)cur.pn * tstepB;
  PG8_WAIT_V(0);
  LAS float* const rsl = (LAS float*)(lds + STAGE_BYTES);
  sq_t pre_v = 0;
  if (Epi::HAS_PRE) { const sq_t* pp = E.pre_ptr(); if (pp && tid < 256) pre_v = pp[cur.pm * 256 + tid]; }
  PG8_STAGE(PG8_SB(0, 0), cB, voffB); PG8_STAGE(PG8_SB(0, 1), cB + hstepB, voffB); PG8_STAGE(PG8_SA(0, 0), cA, voffA); PG8_STAGE(PG8_SA(0, 1), cA + hstepA, voffA);
  if (wr == 1) PG8_BAR;
  PG8_WAIT_V(2); PG8_BAR;
  PG8_STAGE(PG8_SB(1, 0), cB + kstep, voffB); PG8_STAGE(PG8_SA(1, 0), cA + kstep, voffA); PG8_STAGE(PG8_SB(1, 1), cB + hstepB + kstep, voffB);
  PG8_WAIT_V(6); PG8_BAR;
  for (;;) {
    const bool has_next = S.next(ui + 1, nxt);
    const char* nA = has_next ? (const char*)g.A + (size_t)nxt.z * SA_ + (size_t)nxt.pm * tstepA : cA;
    const char* nB = has_next ? (const char*)g.Bt + (size_t)nxt.z * SB_ + (size_t)nxt.pn * tstepB : cB;
#pragma nounroll
    for (int t = 0; t < nt; t += 2) {
      const bool last = (t == nt - 2);
      const char* a1 = cA + (size_t)(t + 1) * kstep;
      const char* a2 = last ? nA : cA + (size_t)(t + 2) * kstep; const char* b2 = last ? nB : cB + (size_t)(t + 2) * kstep;
      const char* a3 = a2 + kstep; const char* b3 = b2 + kstep;
      PG8_LDB(B0, 0, 0); PG8_LDB(B1, 0, 1); PG8_SCHED; PG8_LDA(At, 0, 0); PG8_STAGE(PG8_SA(1, 1), a1 + hstepA, voffA);
      PG8_WAIT_V(8); PG8_WAIT_L(0); PG8_BAR; PG8_MMA(0, 0, At, B0); PG8_MMA(0, 1, At, B1); PG8_BAR; PG8_SCHED;
      PG8_LDA(At, 0, 1); PG8_STAGE(PG8_SB(0, 0), b2, voffB); PG8_STAGE(PG8_SB(0, 1), b2 + hstepB, voffB); PG8_STAGE(PG8_SA(0, 0), a2, voffA);
      PG8_WAIT_V(8); PG8_WAIT_L(0); PG8_BAR; PG8_MMA(1, 0, At, B0); PG8_MMA(1, 1, At, B1); PG8_BAR; PG8_SCHED;
      PG8_LDB(B0, 1, 0); PG8_LDB(B1, 1, 1); PG8_SCHED; PG8_LDA(At, 1, 0); PG8_STAGE(PG8_SA(0, 1), a2 + hstepA, voffA);
      PG8_WAIT_V(8); PG8_WAIT_L(0); PG8_BAR; PG8_MMA(0, 0, At, B0); PG8_MMA(0, 1, At, B1); PG8_BAR; PG8_SCHED;
      PG8_LDA(At, 1, 1); PG8_STAGE(PG8_SB(1, 0), b3, voffB); PG8_STAGE(PG8_SB(1, 1), b3 + hstepB, voffB); PG8_STAGE(PG8_SA(1, 0), a3, voffA);
      PG8_WAIT_V(8); PG8_WAIT_L(0); PG8_BAR; PG8_MMA(1, 0, At, B0); PG8_MMA(1, 1, At, B1); PG8_BAR; PG8_SCHED;
    }
    if (Epi::HAS_PRE) { if (tid < 256) { rsl[tid] = rs_of(pre_v, E.pre_invn()); PG8_WAIT_L(0); } }
    if (wr == 0) PG8_BAR;
    E(acc, cur, wr, wc, fr, fq, rsl);
    if (!has_next) break;
#pragma unroll
    for (int a = 0; a < 2; ++a)
#pragma unroll
      for (int b = 0; b < 2; ++b)
#pragma unroll
        for (int m = 0; m < 4; ++m)
#pragma unroll
          for (int n = 0; n < 2; ++n) acc[a][b][m][n] = (f32x4){0.f, 0.f, 0.f, 0.f};
    cur = nxt; cA = nA; cB = nB; ++ui;
    if (Epi::HAS_PRE) { const sq_t* pp = E.pre_ptr(); if (pp && tid < 256) pre_v = pp[cur.pm * 256 + tid]; }
    if (wr == 1) PG8_BAR;
  }
  PG8_WAIT_V(0);
  PG8_BAR;
#undef PG8_SA
#undef PG8_SB
#undef PG8_STAGE
#undef PG8_LDA
#undef PG8_LDB
#undef PG8_MMA
#undef PG8_WAIT_V
#undef PG8_WAIT_L
#undef PG8_BAR
#undef PG8_SCHED
}
}
using pg8::Unit;
typedef f32x4 AccT[2][2][4][2];

#define EPI_HDR __device__ __forceinline__ void operator()(const AccT& acc, const Unit& u, int wr, int wc, int fr, int fq, const LAS float* rsl) const
#define NO_PRE static constexpr bool HAS_PRE = false; __device__ __forceinline__ const sq_t* pre_ptr() const { return nullptr; } __device__ __forceinline__ float pre_invn() const { return 1.f; }
#define PRE(ptr, invn) static constexpr bool HAS_PRE = true; __device__ __forceinline__ const sq_t* pre_ptr() const { return (ptr); } __device__ __forceinline__ float pre_invn() const { return (invn); }

struct EpiSwiglu {
  bf16_t* G; const sq_t* sq;
  PRE(sq, 1.f / 1024.f)
  EPI_HDR {
#pragma unroll
    for (int ai = 0; ai < 2; ++ai)
#pragma unroll
      for (int m = 0; m < 4; ++m) {
        const int row = u.pm * 256 + ai * 128 + wr * 64 + m * 16 + fr;
        const float rs = rsl[ai * 128 + wr * 64 + m * 16 + fr];
        f32x4 o0, o1;
#pragma unroll
        for (int j = 0; j < 4; ++j) { o0[j] = siluf_(acc[ai][0][m][0][j] * rs) * (acc[ai][1][m][0][j] * rs); o1[j] = siluf_(acc[ai][0][m][1][j] * rs) * (acc[ai][1][m][1][j] * rs); }
        *(u32x4*)(G + (size_t)row * FF + u.pn * 128 + wc * 32 + 8 * fq) = pack8(o0, o1);
      }
  }
};

template <int MODE> struct EpiResid {
  const float* res32; const bf16_t* res16; float* out32; bf16_t* hb; sq_t* sq_out; float alpha; const bf16_t* U; const sq_t* sq_in;
  PRE(sq_in, 1.f / 1024.f)
  EPI_HDR {
#pragma unroll
    for (int ai = 0; ai < 2; ++ai)
#pragma unroll
      for (int m = 0; m < 4; ++m) {
        const int row = u.pm * 256 + ai * 128 + wr * 64 + m * 16 + fr;
        float rs = 0.f; if (MODE == 1) rs = rsl[ai * 128 + wr * 64 + m * 16 + fr];
        float part = 0.f;
#pragma unroll
        for (int bj = 0; bj < 2; ++bj) {
          const size_t off = (size_t)row * DM + u.pn * 256 + bj * 128 + wc * 32 + 8 * fq;
          f32x4 r0, r1;
          if (res32) { r0 = *(const f32x4*)(res32 + off); r1 = *(const f32x4*)(res32 + off + 4); }
          else unpack8(*(const u32x4*)(res16 + off), r0, r1);
          f32x4 h0, h1;
          if (MODE == 0) { h0 = r0 + alpha * acc[ai][bj][m][0]; h1 = r1 + alpha * acc[ai][bj][m][1]; }
          else { f32x4 u0, u1; unpack8(*(const u32x4*)(U + off), u0, u1);
#pragma unroll
            for (int j = 0; j < 4; ++j) { h0[j] = r0[j] + u0[j] * sigmoidf_(rs * acc[ai][bj][m][0][j]); h1[j] = r1[j] + u1[j] * sigmoidf_(rs * acc[ai][bj][m][1][j]); } }
          if (out32) { *(f32x4*)(out32 + off) = h0; *(f32x4*)(out32 + off + 4) = h1; }
          if (hb) *(u32x4*)(hb + off) = pack8(h0, h1);
#pragma unroll
          for (int j = 0; j < 4; ++j) part += h0[j] * h0[j] + h1[j] * h1[j];
        }
        part += shx(part, 16); part += shx(part, 32);
        if (fq == 0) sq_add(sq_out + row, part);
      }
  }
};

struct EpiStore {
  bf16_t* O; int ldo; const sq_t* sq; float inv_n;
  PRE(sq, inv_n)
  EPI_HDR {
#pragma unroll
    for (int ai = 0; ai < 2; ++ai)
#pragma unroll
      for (int m = 0; m < 4; ++m) {
        const int row = u.pm * 256 + ai * 128 + wr * 64 + m * 16 + fr;
        const float rs = sq ? rsl[ai * 128 + wr * 64 + m * 16 + fr] : 1.f;
#pragma unroll
        for (int bj = 0; bj < 2; ++bj)
          *(u32x4*)(O + (size_t)row * ldo + u.pn * 256 + bj * 128 + wc * 32 + 8 * fq) = pack8(acc[ai][bj][m][0] * rs, acc[ai][bj][m][1] * rs);
      }
  }
};

struct EpiKV {
  bf16_t* KV; bf16_t* VT; const sq_t* sq;
  PRE(sq, 1.f / 256.f)
  EPI_HDR {
#pragma unroll
    for (int ai = 0; ai < 2; ++ai)
#pragma unroll
      for (int m = 0; m < 4; ++m) {
        const int row = u.pm * 256 + ai * 128 + wr * 64 + m * 16 + fr;
        const float rs = rsl[ai * 128 + wr * 64 + m * 16 + fr];
#pragma unroll
        for (int bj = 0; bj < 2; ++bj) {
          const int col = u.pn * 256 + bj * 128 + wc * 32 + 8 * fq;
          const u32x4 w = pack8(acc[ai][bj][m][0] * rs, acc[ai][bj][m][1] * rs);
          if (wc < 2) *(u32x4*)(KV + (size_t)row * 1024 + col) = w;
          else { bf16_t* vt = VT + ((size_t)((row >> 13) * 8 + (col >> 7)) * 64 + (col & 63)) * SEQ + (row & (SEQ - 1));
#pragma unroll
            for (int e = 0; e < 4; ++e) { vt[(size_t)(2 * e) * SEQ] = (bf16_t)(w[e] & 0xffffu); vt[(size_t)(2 * e + 1) * SEQ] = (bf16_t)(w[e] >> 16); } }
        }
      }
  }
};

struct EpiWinEven {
  bf16_t* Y; const sq_t* sq; sq_t* sq_q; sq_t* sq_kv;
  PRE(sq, 1.f / 1024.f)
  EPI_HDR {
#pragma unroll
    for (int ai = 0; ai < 2; ++ai)
#pragma unroll
      for (int m = 0; m < 4; ++m) {
        const int row = u.pm * 256 + ai * 128 + wr * 64 + m * 16 + fr;
        const float rs = rsl[ai * 128 + wr * 64 + m * 16 + fr];
#pragma unroll
        for (int bj = 0; bj < 2; ++bj) {
          const f32x4 v0 = acc[ai][bj][m][0] * rs, v1 = acc[ai][bj][m][1] * rs;
          *(u32x4*)(Y + (size_t)row * YLD + u.pn * 256 + bj * 128 + wc * 32 + 8 * fq) = pack8(v0, v1);
          const int seg = 2 * u.pn + bj;
          if (seg < 5) {
            float part = 0.f;
#pragma unroll
            for (int j = 0; j < 4; ++j) part += v0[j] * v0[j] + v1[j] * v1[j];
            part += shx(part, 16); part += shx(part, 32);
            if (fq == 0) sq_add((seg < 3 ? sq_q : sq_kv) + row, part);
          }
        }
      }
  }
};

struct EpiQ {
  bf16_t* Q; const sq_t* sq_q; const float* rope;
  PRE(sq_q, 1.f / 384.f)
  EPI_HDR {
    const float QS = 0.10206207261596575f * 1.4426950408889634f;
#pragma unroll
    for (int ai = 0; ai < 2; ++ai)
#pragma unroll
      for (int m = 0; m < 4; ++m) {
        const int row = u.pm * 256 + ai * 128 + wr * 64 + m * 16 + fr;
        const float rs = rsl[ai * 128 + wr * 64 + m * 16 + fr] * QS;
        const int pos = row & (SEQ - 1);
#pragma unroll
        for (int bj = 0; bj < 2; ++bj) {
          const int colg = u.pn * 256 + bj * 128 + wc * 32;
          f32x4 v0 = acc[ai][bj][m][0] * rs, v1 = acc[ai][bj][m][1] * rs;
          if (((colg >> 5) % 3) == 2) {
            const float* cs = rope + ((size_t)pos * 16 + 8 * (fq & 1)) * 2;
            const f32x4 c0 = *(const f32x4*)(cs), c1 = *(const f32x4*)(cs + 4), c2 = *(const f32x4*)(cs + 8), c3 = *(const f32x4*)(cs + 12);
            const float co[8] = {c0[0], c0[2], c1[0], c1[2], c2[0], c2[2], c3[0], c3[2]};
            const float si[8] = {c0[1], c0[3], c1[1], c1[3], c2[1], c2[3], c3[1], c3[3]};
#pragma unroll
            for (int j = 0; j < 4; ++j) {
              const float p0 = shx(v0[j], 32), p1 = shx(v1[j], 32);
              if (fq < 2) { v0[j] = v0[j] * co[j] - p0 * si[j]; v1[j] = v1[j] * co[4 + j] - p1 * si[4 + j]; }
              else { v0[j] = p0 * si[j] + v0[j] * co[j]; v1[j] = p1 * si[4 + j] + v1[j] * co[4 + j]; }
            }
          }
          *(u32x4*)(Q + (size_t)row * 768 + colg + 8 * fq) = pack8(v0, v1);
        }
      }
  }
};

struct EpiWinOdd {
  bf16_t* Yo; bf16_t* Upk; const sq_t* sq;
  PRE(sq, 1.f / 1024.f)
  EPI_HDR {
#pragma unroll
    for (int ai = 0; ai < 2; ++ai)
#pragma unroll
      for (int m = 0; m < 4; ++m) {
        const int row = u.pm * 256 + ai * 128 + wr * 64 + m * 16 + fr;
        const float rs = rsl[ai * 128 + wr * 64 + m * 16 + fr];
#pragma unroll
        for (int bj = 0; bj < 2; ++bj) {
          const int col = u.pn * 256 + bj * 128 + wc * 32 + 8 * fq;
          const u32x4 w = pack8(acc[ai][bj][m][0] * rs, acc[ai][bj][m][1] * rs);
          if (u.pn < 4) *(u32x4*)(Yo + (size_t)row * 1024 + col) = w;
          else { const int cu = col - 1024, g = cu >> 4, ci = cu & 15; *(u32x4*)(Upk + ((size_t)g * 1024 + (row >> 5)) * 640 + (row & 31) * 16 + ci) = w; }
        }
      }
  }
};

struct EpiZ {
  float* Z;
  NO_PRE
  EPI_HDR {
#pragma unroll
    for (int ai = 0; ai < 2; ++ai)
#pragma unroll
      for (int m = 0; m < 4; ++m) {
        const int row = u.pm * 256 + ai * 128 + wr * 64 + m * 16 + fr;
        float* p = Z + ((size_t)row * 32 + u.z) * 128 + wc * 32 + 8 * fq;
        *(f32x4*)p = acc[ai][0][m][0]; *(f32x4*)(p + 4) = acc[ai][0][m][1];
      }
  }
};

struct EpiRG {
  bf16_t* la; bf16_t* bx; const bf16_t* xc; const float* b_a; const float* b_i; const float* c8sp;
  NO_PRE
  EPI_HDR {
    const int c0 = u.pn * 128 + wc * 32 + 8 * fq;
    float ba[8], bi[8], cs[8];
#pragma unroll
    for (int j = 0; j < 8; ++j) { ba[j] = b_a[c0 + j]; bi[j] = b_i[c0 + j]; cs[j] = c8sp[c0 + j]; }
#pragma unroll
    for (int ai = 0; ai < 2; ++ai)
#pragma unroll
      for (int m = 0; m < 4; ++m) {
        const int row = u.pm * 256 + ai * 128 + wr * 64 + m * 16 + fr;
        f32x4 x0, x1; unpack8(*(const u32x4*)(xc + (size_t)row * 512 + c0), x0, x1);
        f32x4 l0, l1, o0, o1;
#pragma unroll
        for (int j = 0; j < 4; ++j) {
          { const float r = sigmoidf_(acc[ai][0][m][0][j] + ba[j]), ig = sigmoidf_(acc[ai][1][m][0][j] + bi[j]);
            const float lg = -cs[j] * r; l0[j] = lg; o0[j] = __builtin_amdgcn_sqrtf(one_minus_exp(2.f * lg)) * (ig * x0[j]); }
          { const float r = sigmoidf_(acc[ai][0][m][1][j] + ba[4 + j]), ig = sigmoidf_(acc[ai][1][m][1][j] + bi[4 + j]);
            const float lg = -cs[4 + j] * r; l1[j] = lg; o1[j] = __builtin_amdgcn_sqrtf(one_minus_exp(2.f * lg)) * (ig * x1[j]); }
        }
        *(u32x4*)(la + (size_t)row * 512 + c0) = pack8(l0, l1);
        *(u32x4*)(bx + (size_t)row * 512 + c0) = pack8(o0, o1);
      }
  }
};

struct EpiS5Y {
  bf16_t* yg; const bf16_t* Upk; const float* dpar;
  NO_PRE
  EPI_HDR {
    const int g = u.z;
#pragma unroll
    for (int ai = 0; ai < 2; ++ai)
#pragma unroll
      for (int m = 0; m < 4; ++m) {
        const int row = u.pm * 256 + ai * 128 + wr * 64 + m * 16 + fr;
#pragma unroll
        for (int bj = 0; bj < 2; ++bj) {
          const int col = u.pn * 256 + bj * 128 + wc * 32 + 8 * fq, t = col >> 4, co = col & 15;
          f32x4 u0, u1; unpack8(*(const u32x4*)(Upk + ((size_t)g * 1024 + row) * 640 + col), u0, u1);
          const f32x4 d0 = *(const f32x4*)(dpar + g * 16 + co), d1 = *(const f32x4*)(dpar + g * 16 + co + 4);
          f32x4 y0, y1;
#pragma unroll
          for (int j = 0; j < 4; ++j) { y0[j] = geluf_(acc[ai][bj][m][0][j] + d0[j] * u0[j]); y1[j] = geluf_(acc[ai][bj][m][1][j] + d1[j] * u1[j]); }
          *(u32x4*)(yg + ((size_t)row * 32 + t) * 512 + g * 16 + co) = pack8(y0, y1);
        }
      }
  }
};

struct EpiGLU {
  bf16_t* mix; const bf16_t* yg; const float* b;
  NO_PRE
  EPI_HDR {
#pragma unroll
    for (int ai = 0; ai < 2; ++ai)
#pragma unroll
      for (int m = 0; m < 4; ++m) {
        const int row = u.pm * 256 + ai * 128 + wr * 64 + m * 16 + fr;
#pragma unroll
        for (int bj = 0; bj < 2; ++bj) {
          const int col = u.pn * 256 + bj * 128 + wc * 32 + 8 * fq;
          f32x4 y0, y1; unpack8(*(const u32x4*)(yg + (size_t)row * 512 + col), y0, y1);
          const f32x4 b0 = *(const f32x4*)(b + col), b1 = *(const f32x4*)(b + col + 4);
          f32x4 o0, o1;
#pragma unroll
          for (int j = 0; j < 4; ++j) { o0[j] = y0[j] * sigmoidf_(acc[ai][bj][m][0][j] + b0[j]); o1[j] = y1[j] * sigmoidf_(acc[ai][bj][m][1][j] + b1[j]); }
          *(u32x4*)(mix + (size_t)row * 1024 + 512 + col) = pack8(o0, o1);
        }
      }
  }
};

#define XB_TMO      128
#define XB_XCNT(j)  (256  + 64 * (j))
#define XB_XSUB(j)  (1280 + 64 * (j))
#define XB_XGEN(j)  (2304 + 64 * (j))
#define XB_TOP      3328
#define XB_TOPGEN   3392
#define XCD_BAR_WORDS 3456
#define XB_SPIN_CAP (1u << 18)

__device__ __forceinline__ unsigned xb_ld(unsigned* p)              { return __hip_atomic_load(p, __ATOMIC_RELAXED, __HIP_MEMORY_SCOPE_AGENT); }
__device__ __forceinline__ unsigned xb_add(unsigned* p, unsigned v) { return __hip_atomic_fetch_add(p, v, __ATOMIC_RELAXED, __HIP_MEMORY_SCOPE_AGENT); }
__device__ __forceinline__ unsigned xb_xcc_id() { return (unsigned)__builtin_amdgcn_s_getreg((3 << 11) | 20) & 0xFu; }
#define XB_SPIN(cond, bar) do { unsigned _sp = 0; while (cond) { __builtin_amdgcn_s_sleep(1); \
    if ((++_sp & 255u) == 0u) { if (xb_ld(&(bar)[XB_TMO])) break; if (_sp > XB_SPIN_CAP) { atomicAdd(&(bar)[XB_TMO], 1u); break; } } } } while (0)

struct XcdBarrier {
    unsigned* bar; unsigned x;
    volatile LAS unsigned* st;
};

__device__ __forceinline__ XcdBarrier xcd_barrier_post(unsigned* bar, volatile LAS unsigned* st) {
    XcdBarrier b; b.bar = bar; b.x = xb_xcc_id(); b.st = st;
    if (threadIdx.x == 0) (void)xb_add(&bar[XB_XCNT(b.x)], 1u);
    return b;
}
__device__ __forceinline__ void xcd_barrier_complete(unsigned* bar, unsigned x, unsigned& nloc, unsigned& nx) {
    const unsigned G = gridDim.x * gridDim.y * gridDim.z;
    unsigned sum, cnt, mine, sp = 0u;
    for (;;) {
        sum = 0u; cnt = 0u; mine = 0u;
#pragma unroll
        for (unsigned j = 0; j < 16; ++j) { const unsigned c = xb_ld(&bar[XB_XCNT(j)]); sum += c; cnt += (c > 0u) ? 1u : 0u; mine = (j == x) ? c : mine; }
        if (sum == G) break;
        __builtin_amdgcn_s_sleep(1);
        if ((++sp & 255u) == 0u) { if (xb_ld(&bar[XB_TMO])) break; if (sp > XB_SPIN_CAP) { atomicAdd(&bar[XB_TMO], 1u); break; } }
    }
    nloc = mine > 0u ? mine : 1u; nx = cnt > 0u ? cnt : 1u;
}

__device__ __forceinline__ void xcd_barrier(const XcdBarrier& b) {
    asm volatile("s_waitcnt vmcnt(0)" ::: "memory");
    __syncthreads();
    if (threadIdx.x == 0) {
        unsigned* bar = b.bar;
        __builtin_amdgcn_s_waitcnt(0);
        unsigned nloc = b.st[0], nx = b.st[1];
        if (nloc == 0u) { xcd_barrier_complete(bar, b.x, nloc, nx); b.st[0] = nloc; b.st[1] = nx; }
        const unsigned old = xb_add(&bar[XB_XSUB(b.x)], 1u);
        const unsigned gen = old / nloc;
        if (old + 1u == (gen + 1u) * nloc) {
            __builtin_amdgcn_fence(__ATOMIC_RELEASE, "agent");
            asm volatile("s_waitcnt vmcnt(0)" ::: "memory");
            const unsigned og = xb_add(&bar[XB_TOP], 1u);
            const unsigned tg = og / nx;
            if (og + 1u == (tg + 1u) * nx) xb_add(&bar[XB_TOPGEN], 1u);
            else XB_SPIN(xb_ld(&bar[XB_TOPGEN]) == tg, bar);
            __builtin_amdgcn_fence(__ATOMIC_ACQUIRE, "agent");
            xb_add(&bar[XB_XGEN(b.x)], 1u);
            asm volatile("s_waitcnt vmcnt(0)" ::: "memory");
        } else {
            XB_SPIN(xb_ld(&bar[XB_XGEN(b.x)]) == gen, bar);
            __builtin_amdgcn_fence(__ATOMIC_ACQUIRE, "agent");
            asm volatile("s_waitcnt vmcnt(0)" ::: "memory");
        }
    }
    __syncthreads();
}

struct Frame {
  LAS uchar* lds; int tid, lane, wave, bid, G;
  sq_t* stat; uchar* ws; float* out; XcdBarrier xb;
};
__device__ __forceinline__ sq_t* statp(const Frame& F, int i) { return F.stat + (size_t)i * T; }
template <int M_, int N_, int K_, int LDA_, int NZ_ = 1, size_t SA_ = 0, size_t SB_ = 0, class Epi>
__device__ __forceinline__ void run_gemm(const Frame& F, const bf16_t* A, const bf16_t* Bt, const Epi& E, int Gsub = -1, int c = -2) {
  pg8::Order<M_, N_, NZ_> S; S.init(Gsub < 0 ? F.G : Gsub, c == -2 ? F.bid : c);
  pg8::Gemm g; g.A = A; g.Bt = Bt;
  pg8::gemm_phase<Epi, M_, N_, K_, LDA_, NZ_, SA_, SB_>(F.lds, g, S, E);
}

struct TJob { const float* src; const float* scale; bf16_t* dst; int K, N, map; };
__device__ __forceinline__ int rowmap(int map, int n) {
  if (map == 0) return n;
  if (map == 1) return 256 * (n >> 7) + (n & 127);
  if (map == 2) return 256 * (n >> 7) + 128 + (n & 127);
  if (n < 640) return n;
  if (n < 672) return YC_KR + (n - 640);
  if (n < 1696) return n - 32;
  if (n < 1712) return YC_GLOW + (n - 1696);
  return YC_GR + (n - 1712);
}
constexpr int NJOB = 23;
__device__ __forceinline__ TJob tjob(const Frame& F, int j) {
  bf16_t* W = (bf16_t*)(F.ws + WS_W);
  TJob t; t.scale = nullptr; t.map = 0;
  if (j < 12) {
    const int q = j / 3, which = j % 3, l = q >> 1, ab = q & 1;
    const float* nrm = IN_(ab ? 7 : 2) + l * 1024;
    if (which == 0) { t.src = IN_(ab ? 8 : 3) + (size_t)l * 1024 * FF; t.scale = nrm; t.dst = (bf16_t*)((uchar*)W + WO_W13 + q * W13_B); t.K = 1024; t.N = FF; t.map = 1; }
    else if (which == 1) { t.src = IN_(ab ? 9 : 4) + (size_t)l * 1024 * FF; t.scale = nrm; t.dst = (bf16_t*)((uchar*)W + WO_W13 + q * W13_B); t.K = 1024; t.N = FF; t.map = 2; }
    else { t.src = IN_(ab ? 10 : 5) + (size_t)l * FF * 1024; t.dst = (bf16_t*)((uchar*)W + WO_W2 + q * W2_B); t.K = FF; t.N = 1024; }
  } else if (j < 16) {
    const int l = (j - 12) >> 1, which = (j - 12) & 1;
    if (which == 0) { t.src = IN_(12) + (size_t)l * 1024 * 1024; t.scale = IN_(11) + l * 1024; t.dst = (bf16_t*)((uchar*)W + WO_WG + (size_t)l * 1024 * 1024 * 2); t.K = 1024; t.N = 1024; }
    else { t.src = IN_(13) + (size_t)l * 256 * 1024; t.dst = (bf16_t*)((uchar*)W + WO_WUP + (size_t)l * 1024 * 256 * 2); t.K = 256; t.N = 1024; }
  } else if (j == 16) { t.src = IN_(14); t.scale = IN_(6); t.dst = (bf16_t*)((uchar*)W + WO_WINE); t.K = 1024; t.N = 2224; t.map = 3; }
  else if (j == 17) { t.src = IN_(16); t.scale = IN_(15); t.dst = (bf16_t*)((uchar*)W + WO_WQ); t.K = 384; t.N = 768; }
  else if (j == 18) { t.src = IN_(18); t.scale = IN_(17); t.dst = (bf16_t*)((uchar*)W + WO_WKV); t.K = 256; t.N = 1024; }
  else if (j == 19) { t.src = IN_(22); t.dst = (bf16_t*)((uchar*)W + WO_WOUTE); t.K = 1024; t.N = 1024; }
  else if (j == 20) { t.src = IN_(23); t.scale = IN_(6) + 1024; t.dst = (bf16_t*)((uchar*)W + WO_WINO); t.K = 1024; t.N = 1536; }
  else if (j == 21) { t.src = IN_(39); t.dst = (bf16_t*)((uchar*)W + WO_WGLU); t.K = 512; t.N = 512; }
  else { t.src = IN_(41); t.dst = (bf16_t*)((uchar*)W + WO_WOUTO); t.K = 1024; t.N = 1024; }
  return t;
}
__device__ __forceinline__ int tjob_tiles(int K, int N) { return (K >> 7) * ((N + 63) >> 6); }

struct TLoad { f32x4 v[4]; float s[4]; };
__device__ __forceinline__ TLoad trans_load(const TJob& j, int tile, int tid) {
  const int ntn = (j.N + 63) >> 6, kt = tile / ntn, nt_ = tile % ntn, k0 = kt * 128, n0 = nt_ * 64;
  TLoad L;
#pragma unroll
  for (int i = 0; i < 4; ++i) {
    const int kk = (tid >> 4) + 32 * i, n4 = (tid & 15) * 4;
    L.v[i] = (f32x4){0.f, 0.f, 0.f, 0.f};
    if (n0 + n4 < j.N) L.v[i] = *(const f32x4*)(j.src + (size_t)(k0 + kk) * j.N + n0 + n4);
    L.s[i] = j.scale ? j.scale[k0 + kk] : 1.f;
  }
  return L;
}
__device__ __forceinline__ void trans_store(const TJob& j, int tile, const TLoad& L, LAS float* sm, int tid) {
  const int ntn = (j.N + 63) >> 6, kt = tile / ntn, nt_ = tile % ntn, k0 = kt * 128, n0 = nt_ * 64;
#pragma unroll
  for (int i = 0; i < 4; ++i) {
    const int kk = (tid >> 4) + 32 * i, n4 = (tid & 15) * 4;
#pragma unroll
    for (int e = 0; e < 4; ++e) sm[kk * 65 + n4 + e] = L.v[i][e] * L.s[i];
  }
  __syncthreads();
  { const int n = tid >> 3, k8 = (tid & 7) * 8;
    if (n0 + n < j.N) {
      bf16_t* drow = j.dst + (size_t)rowmap(j.map, n0 + n) * j.K + k0;
#pragma unroll
      for (int ps = 0; ps < 2; ++ps) {
        f32x4 a, b;
#pragma unroll
        for (int e = 0; e < 4; ++e) { a[e] = sm[(64 * ps + k8 + e) * 65 + n]; b[e] = sm[(64 * ps + k8 + 4 + e) * 65 + n]; }
        *(u32x4*)(drow + 64 * ps + k8) = pack8(a, b);
      }
    } }
  __syncthreads();
}
__host__ __device__ constexpr int job_tiles(int j) {
  return j < 12 ? 352 : (j == 12 || j == 14) ? 128 : (j == 13 || j == 15) ? 32 : j == 16 ? 280 : j == 17 ? 36 : j == 18 ? 32 : j == 19 ? 128 : j == 20 ? 192 : j == 21 ? 32 : 128;
}
__device__ __forceinline__ bool tile_lookup(const Frame& F, int gt, TJob& tj, int& tile) {
  int base = 0, jf = -1;
#pragma unroll
  for (int j = 0; j < NJOB; ++j) { const int n = job_tiles(j); if (jf < 0 && gt < base + n) { jf = j; tile = gt - base; } base += n; }
  if (jf < 0) return false;
  tj = tjob(F, jf);
  return true;
}

__device__ __forceinline__ void s5_group_item(const Args& a, const Frame& F, int g) {
  LAS float* sm = (LAS float*)F.lds;
  LAS float* ApR = sm;
  LAS float* ApI = sm + 2112;
  LAS float* bbR = sm + 4224;
  LAS float* bbI = sm + 5248;
  LAS float* CR = sm + 6272;
  LAS float* CI = sm + 7296;
  LAS float* Kt = sm + 8320;
  const int tid = F.tid;
  const float* a_re = IN_(31); const float* a_im = IN_(32); const float* log_dt = IN_(33);
  const float* b_re = IN_(34); const float* b_im = IN_(35); const float* c_re = IN_(36); const float* c_im = IN_(37);
  if (tid < 64) {
    const int p = tid;
    const double dt = exp((double)log_dt[g]);
    const double lr = a_re[g * 64 + p], li = a_im[g * 64 + p];
    const double mag = exp(lr * dt); double sn, cs; sincos_acc(li * dt, sn, cs);
    const double ar = mag * cs, aim = mag * sn;
    const double den = lr * lr + li * li, nr = ar - 1.0, ni = aim;
    const double cr = (nr * lr + ni * li) / den, ci = (ni * lr - nr * li) / den;
    double pr = 1.0, pi = 0.0;
    for (int t = 0; t <= 32; ++t) { ApR[p * 33 + t] = (float)pr; ApI[p * 33 + t] = (float)pi; const double nr2 = pr * ar - pi * aim, ni2 = pr * aim + pi * ar; pr = nr2; pi = ni2; }
    float* AL = (float*)(F.ws + WS_AL);
    AL[(g * 64 + p) * 2] = ApR[p * 33 + 32]; AL[(g * 64 + p) * 2 + 1] = ApI[p * 33 + 32];
    for (int c = 0; c < 16; ++c) {
      const double br = b_re[(g * 64 + p) * 16 + c], bi = b_im[(g * 64 + p) * 16 + c];
      bbR[p * 16 + c] = (float)(cr * br - ci * bi); bbI[p * 16 + c] = (float)(cr * bi + ci * br);
    }
  }
  for (int i = tid; i < 1024; i += NTHR) { CR[i] = c_re[g * 1024 + i]; CI[i] = c_im[g * 1024 + i]; }
  __syncthreads();
  { const int tau = tid >> 4, co = tid & 15;
    float acc16[16];
#pragma unroll
    for (int ci = 0; ci < 16; ++ci) acc16[ci] = 0.f;
    for (int p = 0; p < 64; ++p) {
      const float cr = CR[co * 64 + p], ci_ = CI[co * 64 + p], ar = ApR[p * 33 + tau], ai = ApI[p * 33 + tau];
      const float xr = cr * ar - ci_ * ai, xi = cr * ai + ci_ * ar;
#pragma unroll
      for (int ci = 0; ci < 16; ++ci) acc16[ci] += xr * bbR[p * 16 + ci] - xi * bbI[p * 16 + ci];
    }
#pragma unroll
    for (int ci = 0; ci < 16; ++ci) Kt[tid * 16 + ci] = acc16[ci];
  }
  __syncthreads();
  bf16_t* MW = (bf16_t*)(F.ws + WS_W + WO_MW) + (size_t)g * 512 * 640;
  for (int it = tid; it < 512 * 80; it += NTHR) {
    const int row = it / 80, cg8 = it % 80, t = row >> 4, co = row & 15;
    float v[8];
    if (cg8 < 64) { const int s = cg8 >> 1, ci0 = (cg8 & 1) * 8;
#pragma unroll
      for (int j = 0; j < 8; ++j) v[j] = (s <= t) ? Kt[(t - s) * 256 + co * 16 + ci0 + j] : 0.f;
    } else {
#pragma unroll
      for (int j = 0; j < 8; ++j) { const int q = (cg8 - 64) * 8 + j, p = q & 63;
        const float xr = CR[co * 64 + p] * ApR[p * 33 + t + 1] - CI[co * 64 + p] * ApI[p * 33 + t + 1];
        const float xi = CR[co * 64 + p] * ApI[p * 33 + t + 1] + CI[co * 64 + p] * ApR[p * 33 + t + 1];
        v[j] = (q < 64) ? xr : -xi; }
    }
    *(u32x4*)(MW + (size_t)row * 640 + cg8 * 8) = (u32x4){pk2(v[0], v[1]), pk2(v[2], v[3]), pk2(v[4], v[5]), pk2(v[6], v[7])};
  }
  bf16_t* WZ = (bf16_t*)(F.ws + WS_W + WO_WZ) + (size_t)g * 256 * 512;
  for (int it = tid; it < 256 * 64; it += NTHR) {
    const int row = it >> 6, cg8 = it & 63, s = cg8 >> 1, ci0 = (cg8 & 1) * 8;
    float v[8];
#pragma unroll
    for (int j = 0; j < 8; ++j) {
      if (row < 128) { const int p = row & 63; const float pr = ApR[p * 33 + 31 - s], pi = ApI[p * 33 + 31 - s], br = bbR[p * 16 + ci0 + j], bi = bbI[p * 16 + ci0 + j];
        v[j] = (row < 64) ? (pr * br - pi * bi) : (pr * bi + pi * br); }
      else v[j] = 0.f;
    }
    *(u32x4*)(WZ + (size_t)row * 512 + cg8 * 8) = (u32x4){pk2(v[0], v[1]), pk2(v[2], v[3]), pk2(v[4], v[5]), pk2(v[6], v[7])};
  }
  __syncthreads();
}

__device__ __forceinline__ void p0_prologue(const Args& a, const Frame& F) {
  const int tid = F.tid, gtid = F.bid * NTHR + tid, gthreads = F.G * NTHR;
  if (F.G < 160) { for (int g = F.bid; g < 32; g += F.G) s5_group_item(a, F, g); }
  { TJob cj, nj; int ct = 0, nt2 = 0; int gt = F.bid;
    bool have = tile_lookup(F, gt, cj, ct);
    TLoad cl; if (have) cl = trans_load(cj, ct, tid);
    while (have) {
      const bool hn = tile_lookup(F, gt + F.G, nj, nt2);
      TLoad nl; if (hn) nl = trans_load(nj, nt2, tid);
      trans_store(cj, ct, cl, (LAS float*)F.lds, tid);
      if (hn) { cj = nj; ct = nt2; cl = nl; }
      have = hn; gt += F.G;
    } }
  { const float* __restrict__ x = IN_(0); bf16_t* __restrict__ hb = (bf16_t*)(F.ws + WS_HBB); sq_t* __restrict__ sq = statp(F, 0);
    const int gw = F.bid * 8 + F.wave, nw = F.G * 8;
    for (int row = gw; row < T; row += 2 * nw) {
      const int row2 = row + nw; const bool two = row2 < T;
      f32x4 v[4], w[4];
#pragma unroll
      for (int i = 0; i < 4; ++i) { v[i] = *(const f32x4*)(x + (size_t)row * DM + (F.lane + 64 * i) * 4); w[i] = two ? *(const f32x4*)(x + (size_t)row2 * DM + (F.lane + 64 * i) * 4) : (f32x4){0.f, 0.f, 0.f, 0.f}; }
      float ss = 0.f, ss2 = 0.f;
#pragma unroll
      for (int i = 0; i < 4; ++i) { ss += v[i][0] * v[i][0] + v[i][1] * v[i][1] + v[i][2] * v[i][2] + v[i][3] * v[i][3]; ss2 += w[i][0] * w[i][0] + w[i][1] * w[i][1] + w[i][2] * w[i][2] + w[i][3] * w[i][3];
        *(u32x2*)(hb + (size_t)row * DM + (F.lane + 64 * i) * 4) = (u32x2){pk2(v[i][0], v[i][1]), pk2(v[i][2], v[i][3])};
        if (two) *(u32x2*)(hb + (size_t)row2 * DM + (F.lane + 64 * i) * 4) = (u32x2){pk2(w[i][0], w[i][1]), pk2(w[i][2], w[i][3])}; }
#pragma unroll
      for (int o = 32; o >= 1; o >>= 1) { ss += shx(ss, o); ss2 += shx(ss2, o); }
      if (F.lane == 0) { sq[row] = (sq_t)(ss * 16777216.f + 0.5f); if (two) sq[row2] = (sq_t)(ss2 * 16777216.f + 0.5f); }
    } }
  { const float* __restrict__ p = IN_(1); bf16_t* __restrict__ pb = (bf16_t*)(F.ws + WS_PB);
#pragma unroll 4
    for (size_t i = gtid; i < (size_t)2 * T * 256 / 8; i += gthreads) {
      const f32x4 v0 = *(const f32x4*)(p + i * 8), v1 = *(const f32x4*)(p + i * 8 + 4);
      *(u32x4*)(pb + i * 8) = pack8(v0, v1); } }
  { float* rope = (float*)(F.ws + WS_ROPE);
    for (int i = gtid; i < SEQ * 16; i += gthreads) {
      const int pos = i >> 4, k = i & 15;
      const float inv = (float)exp(-(double)k / 16.0 * 9.210340371976184);
      const float ang = (float)pos * inv;
      double s, c; sincos_acc((double)ang, s, c);
      rope[i * 2] = (float)c; rope[i * 2 + 1] = (float)s; } }
  { float* c8 = (float*)(F.ws + WS_C8SP); const float* lam = IN_(30);
    for (int i = gtid; i < 512; i += gthreads) c8[i] = (float)(8.0 * log1p(exp(-(double)lam[i]))); }
  { bf16_t* Wrg = (bf16_t*)(F.ws + WS_W + WO_WRG); const float* w_a = IN_(26); const float* w_i = IN_(28);
    for (int it = gtid; it < 1024 * 64; it += gthreads) {
      const int n = it >> 6, k8 = (it & 63) * 8, within = n & 255, bj = within >> 7, c = (n >> 8) * 128 + (within & 127), hb_ = c >> 6, jj = c & 63;
      float v[8];
#pragma unroll
      for (int e = 0; e < 8; ++e) { const int k = k8 + e; v[e] = ((k >> 6) == hb_) ? (bj ? w_i : w_a)[(hb_ * 64 + (k & 63)) * 64 + jj] : 0.f; }
      *(u32x4*)(Wrg + (size_t)n * 512 + k8) = (u32x4){pk2(v[0], v[1]), pk2(v[2], v[3]), pk2(v[4], v[5]), pk2(v[6], v[7])};
    } }
  { bf16_t* W = (bf16_t*)(F.ws + WS_W + WO_WINE);
    for (int it = gtid; it < 80 * 128; it += gthreads) *(u32x4*)(W + (size_t)(2224 + it / 128) * 1024 + (it % 128) * 8) = (u32x4){0u, 0u, 0u, 0u}; }
}

__device__ __forceinline__ f32x4 mma_lds(f32x4 acc, const LAS bf16_t* A, int lda, const LAS bf16_t* Bt, int ldb, int klen, int lane) {
  const int r = lane & 15, q = lane >> 4;
  for (int k0 = 0; k0 < klen; k0 += 32) {
    const bf16x8 a = *(const LAS bf16x8*)(A + r * lda + k0 + 8 * q);
    const bf16x8 b = *(const LAS bf16x8*)(Bt + r * ldb + k0 + 8 * q);
    acc = __builtin_amdgcn_mfma_f32_16x16x32_bf16(a, b, acc, 0, 0, 0);
  }
  return acc;
}

constexpr int GL_GB = 0;
constexpr int GL_GL = 16384;
constexpr int GL_WG = 20480;
constexpr int GL_QE = 24832;
constexpr int GL_KE = 34048;
constexpr int GL_VT = 43264;
constexpr int GL_ST = 61696;
constexpr int GL_ATT = 80128;
constexpr int GL_OF = 89344;
__device__ __forceinline__ float logsig(float z) { return fminf(z, 0.f) - __logf(1.f + fexp(-fabsf(z))); }

__device__ __forceinline__ void gla_gates(const Args& a, const Frame& F, const bf16_t* Y, int tok0, int h) {
  LAS float* gb = (LAS float*)(F.lds + GL_GB); LAS float* gl = (LAS float*)(F.lds + GL_GL); LAS float* wg = (LAS float*)(F.lds + GL_WG);
  const int tid = F.tid;
  const float* wgu = IN_(19); const float* bg = IN_(20);
  { const int c = tid >> 3, r2 = (tid & 7) * 2; const unsigned w = *(const unsigned*)(Y + (size_t)(tok0 + c) * YLD + YC_GLOW + r2); gl[c * 16 + r2] = bf_lo(w); gl[c * 16 + r2 + 1] = bf_hi(w); }
  for (int i = tid; i < 1024; i += NTHR) wg[i] = wgu[(i >> 6) * 256 + h * 64 + (i & 63)];
  if (tid < 64) wg[1024 + tid] = bg[h * 64 + tid];
  __syncthreads();
  { const int c = tid >> 3, d8 = (tid & 7) * 8;
#pragma unroll
    for (int j = 0; j < 8; ++j) { float z = wg[1024 + d8 + j];
#pragma unroll
      for (int r = 0; r < 16; ++r) z += gl[c * 16 + r] * wg[r * 64 + d8 + j];
      gb[c * 64 + d8 + j] = logsig(z) * (1.f / 16.f); } }
  __syncthreads();
  { const int d = tid & 63, seg = tid >> 6; float s = 0.f;
#pragma unroll
    for (int c = 0; c < 8; ++c) { s += gb[(8 * seg + c) * 64 + d]; gb[(8 * seg + c) * 64 + d] = s; }
    __syncthreads();
    float pre = 0.f;
    for (int sg = 0; sg < seg; ++sg) pre += gb[(8 * sg + 7) * 64 + d];
    __syncthreads();
#pragma unroll
    for (int c = 0; c < 8; ++c) gb[(8 * seg + c) * 64 + d] += pre; }
  __syncthreads();
}

__device__ __forceinline__ void gla_part1(const Args& a, const Frame& F, int item) {
  const bf16_t* Y = (const bf16_t*)(F.ws + WS_Y); bf16_t* CKV = (bf16_t*)(F.ws + WS_CKV) + (size_t)item * 8192; float* decay = (float*)(F.ws + WS_DECAY) + item * 64;
  const int b = item >> 9, h = (item >> 7) & 3, n = item & 127, tok0 = b * SEQ + n * 64, tid = F.tid, lane = F.lane, w = F.wave;
  LAS float* gb = (LAS float*)(F.lds + GL_GB); LAS bf16_t* keT = (LAS bf16_t*)(F.lds + GL_KE); LAS bf16_t* vT = (LAS bf16_t*)(F.lds + GL_VT);
  gla_gates(a, F, Y, tok0, h);
  { const int c = tid & 63, d8 = (tid >> 6) * 8; f32x4 k0, k1; unpack8(*(const u32x4*)(Y + (size_t)(tok0 + c) * YLD + YC_GK + h * 64 + d8), k0, k1);
#pragma unroll
    for (int j = 0; j < 8; ++j) { const float kv = (j < 4 ? k0[j] : k1[j - 4]) * fexp(gb[63 * 64 + d8 + j] - gb[c * 64 + d8 + j]); keT[(d8 + j) * 72 + c] = f2bf1(kv); } }
#pragma unroll
  for (int i = 0; i < 2; ++i) { const int c = tid & 63, e8 = ((tid >> 6) + 8 * i) * 8; const u32x4 wv = *(const u32x4*)(Y + (size_t)(tok0 + c) * YLD + YC_GV + h * 128 + e8);
#pragma unroll
    for (int j = 0; j < 4; ++j) { vT[(e8 + 2 * j) * 72 + c] = (bf16_t)(wv[j] & 0xffffu); vT[(e8 + 2 * j + 1) * 72 + c] = (bf16_t)(wv[j] >> 16); } }
  if (tid < 64) decay[tid] = fexp(gb[63 * 64 + tid]);
  { float* GBg = (float*)F.out + (size_t)24 * 1024 * 1024 + (size_t)item * 4096;
    const int c = tid >> 3, d8 = (tid & 7) * 8;
    *(f32x4*)(GBg + c * 64 + d8) = (f32x4){gb[c * 64 + d8], gb[c * 64 + d8 + 1], gb[c * 64 + d8 + 2], gb[c * 64 + d8 + 3]};
    *(f32x4*)(GBg + c * 64 + d8 + 4) = (f32x4){gb[c * 64 + d8 + 4], gb[c * 64 + d8 + 5], gb[c * 64 + d8 + 6], gb[c * 64 + d8 + 7]}; }
  __syncthreads();
#pragma unroll
  for (int nt_ = 0; nt_ < 4; ++nt_) {
    f32x4 acc = {0.f, 0.f, 0.f, 0.f};
    acc = mma_lds(acc, vT + 16 * w * 72, 72, keT + 16 * nt_ * 72, 72, 64, lane);
#pragma unroll
    for (int j = 0; j < 4; ++j) CKV[(16 * w + 4 * (lane >> 4) + j) * 64 + 16 * nt_ + (lane & 15)] = f2bf1(acc[j]);
  }
  __syncthreads();
}

__device__ __forceinline__ void gla_scan(const Args& a, const Frame& F) {
  bf16_t* CKV = (bf16_t*)(F.ws + WS_CKV); const float* decay = (const float*)(F.ws + WS_DECAY);
  for (int gid = F.bid * NTHR + F.tid; gid < 16 * 8192; gid += F.G * NTHR) {
    const int bh = gid >> 13, el = gid & 8191, d = el & 63;
    float st = 0.f;
    for (int n = 0; n < 128; n += 16) {
      float v[16], dc[16];
#pragma unroll
      for (int i = 0; i < 16; ++i) { const int item = bh * 128 + n + i; v[i] = bf1(CKV[(size_t)item * 8192 + el]); dc[i] = decay[item * 64 + d]; }
#pragma unroll
      for (int i = 0; i < 16; ++i) { const int item = bh * 128 + n + i; CKV[(size_t)item * 8192 + el] = f2bf1(st); st = dc[i] * st + v[i]; }
    }
  }
}

__device__ __forceinline__ void gla_part3(const Args& a, const Frame& F, int item) {
  const bf16_t* Y = (const bf16_t*)(F.ws + WS_Y); const bf16_t* CKV = (const bf16_t*)(F.ws + WS_CKV) + (size_t)item * 8192; bf16_t* mix = (bf16_t*)(F.ws + WS_HBB);
  const int b = item >> 9, h = (item >> 7) & 3, n = item & 127, tok0 = b * SEQ + n * 64, tid = F.tid, lane = F.lane, w = F.wave;
  LAS float* gb = (LAS float*)(F.lds + GL_GB); LAS bf16_t* qe = (LAS bf16_t*)(F.lds + GL_QE); LAS bf16_t* ke = (LAS bf16_t*)(F.lds + GL_KE);
  LAS bf16_t* vT = (LAS bf16_t*)(F.lds + GL_VT); LAS bf16_t* stT = (LAS bf16_t*)(F.lds + GL_ST); LAS bf16_t* att = (LAS bf16_t*)(F.lds + GL_ATT); LAS float* of = (LAS float*)(F.lds + GL_OF);
  { const int c = tid >> 3, d8 = (tid & 7) * 8; f32x4 q0, q1, k0, k1;
    const float* GBg = (const float*)F.out + (size_t)24 * 1024 * 1024 + (size_t)item * 4096 + c * 64 + d8;
    const f32x4 g0 = *(const f32x4*)GBg, g1 = *(const f32x4*)(GBg + 4);
    unpack8(*(const u32x4*)(Y + (size_t)(tok0 + c) * YLD + YC_GQ + h * 64 + d8), q0, q1);
    unpack8(*(const u32x4*)(Y + (size_t)(tok0 + c) * YLD + YC_GK + h * 64 + d8), k0, k1);
#pragma unroll
    for (int j = 0; j < 4; ++j) { const float b0 = g0[j], b1 = g1[j];
      q0[j] *= 0.125f * fexp(b0); q1[j] *= 0.125f * fexp(b1); k0[j] *= fexp(-b0); k1[j] *= fexp(-b1); }
    *(LAS u32x4*)(qe + c * 72 + d8) = pack8(q0, q1); *(LAS u32x4*)(ke + c * 72 + d8) = pack8(k0, k1); }
#pragma unroll
  for (int i = 0; i < 2; ++i) { const int c = tid & 63, e8 = ((tid >> 6) + 8 * i) * 8; const u32x4 wv = *(const u32x4*)(Y + (size_t)(tok0 + c) * YLD + YC_GV + h * 128 + e8);
#pragma unroll
    for (int j = 0; j < 4; ++j) { vT[(e8 + 2 * j) * 72 + c] = (bf16_t)(wv[j] & 0xffffu); vT[(e8 + 2 * j + 1) * 72 + c] = (bf16_t)(wv[j] >> 16); } }
#pragma unroll
  for (int i = 0; i < 2; ++i) { const int q = tid + NTHR * i, e = q >> 3, d8 = (q & 7) * 8; *(LAS u32x4*)(stT + e * 72 + d8) = *(const u32x4*)(CKV + e * 64 + d8); }
  __syncthreads();
#pragma unroll
  for (int i = 0; i < 2; ++i) {
    const int tl = 2 * w + i, mt = tl >> 2, nt_ = tl & 3;
    f32x4 acc = {0.f, 0.f, 0.f, 0.f};
    if (nt_ <= mt) acc = mma_lds(acc, qe + 16 * mt * 72, 72, ke + 16 * nt_ * 72, 72, 64, lane);
#pragma unroll
    for (int j = 0; j < 4; ++j) { const int c = 16 * mt + 4 * (lane >> 4) + j, jj = 16 * nt_ + (lane & 15); att[c * 72 + jj] = f2bf1(jj <= c ? acc[j] : 0.f); }
  }
  __syncthreads();
#pragma unroll
  for (int mt = 0; mt < 4; ++mt) {
    f32x4 acc = {0.f, 0.f, 0.f, 0.f};
    acc = mma_lds(acc, att + 16 * mt * 72, 72, vT + 16 * w * 72, 72, 64, lane);
    acc = mma_lds(acc, qe + 16 * mt * 72, 72, stT + 16 * w * 72, 72, 64, lane);
#pragma unroll
    for (int j = 0; j < 4; ++j) of[(16 * mt + 4 * (lane >> 4) + j) * 132 + 16 * w + (lane & 15)] = acc[j];
  }
  __syncthreads();
  { const int c = tid >> 3, e16 = (tid & 7) * 16; const float* onorm = IN_(21);
    float v[16]; float ss = 0.f;
#pragma unroll
    for (int j = 0; j < 16; ++j) { v[j] = of[c * 132 + e16 + j]; ss += v[j] * v[j]; }
    ss += shx(ss, 1); ss += shx(ss, 2); ss += shx(ss, 4);
    const float rs = __builtin_amdgcn_rsqf(ss * (1.f / 128.f) + EPS);
    f32x4 r0, r1, r2, r3;
    unpack8(*(const u32x4*)(Y + (size_t)(tok0 + c) * YLD + YC_GR + h * 128 + e16), r0, r1);
    unpack8(*(const u32x4*)(Y + (size_t)(tok0 + c) * YLD + YC_GR + h * 128 + e16 + 8), r2, r3);
    const float rr[16] = {r0[0], r0[1], r0[2], r0[3], r1[0], r1[1], r1[2], r1[3], r2[0], r2[1], r2[2], r2[3], r3[0], r3[1], r3[2], r3[3]};
#pragma unroll
    for (int j = 0; j < 16; ++j) v[j] = v[j] * rs * onorm[e16 + j] * siluf_(rr[j]);
    bf16_t* dst = mix + (size_t)(tok0 + c) * 1024 + 512 + h * 128 + e16;
    *(u32x4*)dst = (u32x4){pk2(v[0], v[1]), pk2(v[2], v[3]), pk2(v[4], v[5]), pk2(v[6], v[7])};
    *(u32x4*)(dst + 8) = (u32x4){pk2(v[8], v[9]), pk2(v[10], v[11]), pk2(v[12], v[13]), pk2(v[14], v[15])};
  }
  __syncthreads();
}

constexpr int AT_K = 0;
constexpr int AT_V = 13312;
constexpr int AT_BUF = 22528;
__device__ __forceinline__ void attn_pv(f32x16& o0, f32x16& o1, const bf16x8 (&pf)[4], const LAS bf16_t* Vs, int r, int hh) {
#pragma unroll
  for (int kb = 0; kb < 2; ++kb)
#pragma unroll
    for (int s2 = 0; s2 < 2; ++s2) {
      const int kofs = 32 * kb + 16 * s2 + 4 * hh;
      const u32x2 a00 = *(const LAS u32x2*)(Vs + r * 68 + kofs), a01 = *(const LAS u32x2*)(Vs + r * 68 + kofs + 8);
      const u32x2 a10 = *(const LAS u32x2*)(Vs + (32 + r) * 68 + kofs), a11 = *(const LAS u32x2*)(Vs + (32 + r) * 68 + kofs + 8);
      const u32x4 A0 = {a00[0], a00[1], a01[0], a01[1]}, A1 = {a10[0], a10[1], a11[0], a11[1]};
      o0 = __builtin_amdgcn_mfma_f32_32x32x16_bf16(__builtin_bit_cast(bf16x8, A0), pf[2 * kb + s2], o0, 0, 0, 0);
      o1 = __builtin_amdgcn_mfma_f32_32x32x16_bf16(__builtin_bit_cast(bf16x8, A1), pf[2 * kb + s2], o1, 0, 0, 0);
    }
}
__device__ __forceinline__ void attn_tile(int kt, const LAS bf16_t* Ks, const LAS bf16_t* Vs, const bf16x8 (&qf)[6], f32x16& o0, f32x16& o1, float& mrun, float& lrun, bf16x8 (&pf)[4], bool& pend,
                                          bool grpB, int qw0, int q, int r, int hh) {
  const int k0 = kt * 64;
  if (k0 > qw0 + 31) return;
  f32x16 s0, s1;
  { const f32x16 z16 = {0.f, 0.f, 0.f, 0.f, 0.f, 0.f, 0.f, 0.f, 0.f, 0.f, 0.f, 0.f, 0.f, 0.f, 0.f, 0.f};
    const bf16x8 ka = *(const LAS bf16x8*)(Ks + r * 104 + 8 * hh);
    const bf16x8 kb = *(const LAS bf16x8*)(Ks + (32 + r) * 104 + 8 * hh);
    s0 = __builtin_amdgcn_mfma_f32_32x32x16_bf16(ka, qf[0], z16, 0, 0, 0);
    s1 = __builtin_amdgcn_mfma_f32_32x32x16_bf16(kb, qf[0], z16, 0, 0, 0); }
#pragma unroll
  for (int ks = 1; ks < 6; ++ks) {
    const bf16x8 ka = *(const LAS bf16x8*)(Ks + r * 104 + 16 * ks + 8 * hh);
    const bf16x8 kb = *(const LAS bf16x8*)(Ks + (32 + r) * 104 + 16 * ks + 8 * hh);
    s0 = __builtin_amdgcn_mfma_f32_32x32x16_bf16(ka, qf[ks], s0, 0, 0, 0);
    s1 = __builtin_amdgcn_mfma_f32_32x32x16_bf16(kb, qf[ks], s1, 0, 0, 0);
  }
  if (k0 + 63 > qw0) {
#pragma unroll
    for (int i = 0; i < 16; ++i) { const int key = k0 + (i & 3) + 8 * (i >> 2) + 4 * hh; if (key > q) s0[i] = -1e30f; if (key + 32 > q) s1[i] = -1e30f; }
  }
  float tm = s0[0];
#pragma unroll
  for (int i = 1; i < 16; ++i) tm = fmaxf(tm, s0[i]);
#pragma unroll
  for (int i = 0; i < 16; ++i) tm = fmaxf(tm, s1[i]);
  tm = fmaxf(tm, shx(tm, 32));
  const float mnew = fmaxf(mrun, tm), alpha = __builtin_amdgcn_exp2f(mrun - mnew);
  const int mnew_changed = (mnew != mrun);
  mrun = mnew;
  f32x2_t ps2 = {0.f, 0.f}; const f32x2_t m2 = {mnew, mnew};
#pragma unroll
  for (int i = 0; i < 8; ++i) {
    f32x2_t a = (f32x2_t){s0[2 * i], s0[2 * i + 1]} - m2, b = (f32x2_t){s1[2 * i], s1[2 * i + 1]} - m2;
    a[0] = __builtin_amdgcn_exp2f(a[0]); a[1] = __builtin_amdgcn_exp2f(a[1]); b[0] = __builtin_amdgcn_exp2f(b[0]); b[1] = __builtin_amdgcn_exp2f(b[1]);
    ps2 += a; ps2 += b;
    s0[2 * i] = a[0]; s0[2 * i + 1] = a[1]; s1[2 * i] = b[0]; s1[2 * i + 1] = b[1];
  }
  lrun = lrun * alpha + (ps2[0] + ps2[1]);
  if (__any(mnew_changed)) {
#pragma unroll
    for (int i = 0; i < 16; ++i) { o0[i] *= alpha; o1[i] *= alpha; }
  }
#pragma unroll
  for (int s2 = 0; s2 < 2; ++s2) {
    const u32x4 w0 = {pk2(s0[8 * s2], s0[8 * s2 + 1]), pk2(s0[8 * s2 + 2], s0[8 * s2 + 3]), pk2(s0[8 * s2 + 4], s0[8 * s2 + 5]), pk2(s0[8 * s2 + 6], s0[8 * s2 + 7])};
    const u32x4 w1 = {pk2(s1[8 * s2], s1[8 * s2 + 1]), pk2(s1[8 * s2 + 2], s1[8 * s2 + 3]), pk2(s1[8 * s2 + 4], s1[8 * s2 + 5]), pk2(s1[8 * s2 + 6], s1[8 * s2 + 7])};
    pf[s2] = __builtin_bit_cast(bf16x8, w0); pf[2 + s2] = __builtin_bit_cast(bf16x8, w1);
  }
  if (grpB) pend = true; else attn_pv(o0, o1, pf, Vs, r, hh);
}

__device__ __forceinline__ void attn_unit(const Args& a, const Frame& F, int b, int h, int qb) {
  const bf16_t* Q = (const bf16_t*)(F.ws + WS_Q); const bf16_t* KV = (const bf16_t*)F.out; const bf16_t* KR = (const bf16_t*)(F.ws + WS_KR); bf16_t* mix = (bf16_t*)(F.ws + WS_HBB);
  const int tid = F.tid, lane = F.lane, w = F.wave, r = lane & 31, hh = lane >> 5;
  const size_t tb = (size_t)b * SEQ;
  const int qw0 = qb * 256 + w * 32, q = qw0 + r;
  bf16x8 qf[6];
#pragma unroll
  for (int ks = 0; ks < 6; ++ks) qf[ks] = *(const bf16x8*)(Q + (tb + q) * 768 + h * 96 + 16 * ks + 8 * hh);
  f32x16 o0, o1;
#pragma unroll
  for (int i = 0; i < 16; ++i) { o0[i] = 0.f; o1[i] = 0.f; }
  float mrun = -1e30f, lrun = 0.f;
  const int nkt = 4 * (qb + 1);
  const bool grpB = (w >= 4); bool pend = false;
  bf16x8 pf[4] = {};
  const int kp0 = tid, kp1 = tid + 512;
  const int kk0 = kp0 / 12, kpt0 = kp0 % 12, kk1 = kp1 / 12, kpt1 = kp1 % 12;
  const int vd = tid >> 3, vpart = tid & 7;
  const bf16_t* gk0 = (kpt0 < 8) ? KV + (tb + kk0) * 1024 + h * 128 + 8 * kpt0 : KR + (tb + kk0) * 32 + 8 * (kpt0 - 8); const size_t gs0 = (kpt0 < 8) ? 64 * 1024 : 64 * 32;
  const bf16_t* gk1 = (kpt1 < 8) ? KV + (tb + kk1) * 1024 + h * 128 + 8 * kpt1 : KR + (tb + kk1) * 32 + 8 * (kpt1 - 8); const size_t gs1 = (kpt1 < 8) ? 64 * 1024 : 64 * 32;
  const bf16_t* gv = KV + (size_t)T * 1024 + ((size_t)(b * 8 + h) * 64 + vd) * SEQ + 8 * vpart;
  u32x4 rk0[2], rk1[2] = {{0u, 0u, 0u, 0u}, {0u, 0u, 0u, 0u}}, rv[2];
#define AT_LOAD(S, kt) do { rk0[S] = *(const u32x4*)(gk0 + (size_t)(kt) * gs0); if (kp1 < 768) rk1[S] = *(const u32x4*)(gk1 + (size_t)(kt) * gs1); rv[S] = *(const u32x4*)(gv + (size_t)(kt) * 64); } while (0)
#define AT_TILE_OFF(t) ((((t) >> 1) & 1) * (2 * AT_BUF) + ((t) & 1) * AT_BUF)
#define AT_WRITE(S, kt) do { const int bo = AT_TILE_OFF(kt); \
    LAS bf16_t* Kw = (LAS bf16_t*)(F.lds + AT_K + bo); LAS bf16_t* Vw = (LAS bf16_t*)(F.lds + AT_V + bo); \
    *(LAS u32x4*)(Kw + kk0 * 104 + 8 * kpt0) = rk0[S]; \
    if (kp1 < 768) *(LAS u32x4*)(Kw + kk1 * 104 + 8 * kpt1) = rk1[S]; \
    *(LAS u32x2*)(Vw + vd * 68 + 8 * vpart) = (u32x2){rv[S][0], rv[S][1]}; *(LAS u32x2*)(Vw + vd * 68 + 8 * vpart + 4) = (u32x2){rv[S][2], rv[S][3]}; } while (0)
#define AT_COMPUTE(kt) do { const int bo = AT_TILE_OFF(kt); \
    if (pend) { attn_pv(o0, o1, pf, (const LAS bf16_t*)(F.lds + AT_V + AT_TILE_OFF((kt) - 1)), r, hh); pend = false; } \
    attn_tile((kt), (const LAS bf16_t*)(F.lds + AT_K + bo), (const LAS bf16_t*)(F.lds + AT_V + bo), qf, o0, o1, mrun, lrun, pf, pend, grpB, qw0, q, r, hh); } while (0)
  AT_LOAD(0, 0); AT_LOAD(1, 1);
  __syncthreads();
  AT_WRITE(0, 0); AT_WRITE(1, 1); AT_LOAD(0, 2); AT_LOAD(1, 3);
  for (int kt = 0; kt < nkt; kt += 2) {
    __syncthreads();
    if (kt + 2 < nkt) { AT_WRITE(0, kt + 2); AT_WRITE(1, kt + 3); if (kt + 4 < nkt) { AT_LOAD(0, kt + 4); AT_LOAD(1, kt + 5); } }
    AT_COMPUTE(kt); AT_COMPUTE(kt + 1);
    if (pend) { attn_pv(o0, o1, pf, (const LAS bf16_t*)(F.lds + AT_V + AT_TILE_OFF(kt + 1)), r, hh); pend = false; }
  }
#undef AT_COMPUTE
#undef AT_TILE_OFF
#undef AT_WRITE
#undef AT_LOAD
  const float lt = lrun + shx(lrun, 32), inv = __builtin_amdgcn_rcpf(lt);
  bf16_t* dst = mix + (tb + q) * 1024 + h * 64;
#pragma unroll
  for (int g4 = 0; g4 < 4; ++g4) {
    const int d = 8 * g4 + 4 * hh;
    *(u32x2*)(dst + d) = (u32x2){pk2(o0[4 * g4] * inv, o0[4 * g4 + 1] * inv), pk2(o0[4 * g4 + 2] * inv, o0[4 * g4 + 3] * inv)};
    *(u32x2*)(dst + 32 + d) = (u32x2){pk2(o1[4 * g4] * inv, o1[4 * g4 + 1] * inv), pk2(o1[4 * g4 + 2] * inv, o1[4 * g4 + 3] * inv)};
  }
}

#define PH(k) if (lo <= (k) && (k) < hi)
#define SYNC(k) do { if (lo <= (k) && (k) + 1 < hi) { xcd_barrier(F.xb); } } while (0)
#define WPTR(off) ((const bf16_t*)(F.ws + WS_W + (off)))
#define GTID (F.bid * NTHR + F.tid)
#define GTHREADS (F.G * NTHR)


__device__ __forceinline__ void even_mixer_phases(const Args& a, const Frame& F, int lo, int hi) {
  bf16_t* const hbA = (bf16_t*)(F.ws + WS_HBA); bf16_t* const hbB = (bf16_t*)(F.ws + WS_HBB);
  bf16_t* const Y = (bf16_t*)(F.ws + WS_Y);
  PH(3) { if (F.G >= 160 && F.bid >= 128 && F.bid < 160) s5_group_item(a, F, F.bid - 128);
    EpiWinEven E{Y, statp(F, 1), statp(F, 9), statp(F, 10)}; run_gemm<T, 2304, 1024, 1024>(F, hbA, WPTR(WO_WINE), E); } SYNC(3);
  PH(4) {
    { EpiQ E{(bf16_t*)(F.ws + WS_Q), statp(F, 9), (const float*)(F.ws + WS_ROPE)}; run_gemm<T, 768, 384, YLD>(F, Y, WPTR(WO_WQ), E); }
    { EpiKV E{(bf16_t*)F.out, (bf16_t*)F.out + (size_t)T * 1024, statp(F, 10)}; run_gemm<T, 1024, 256, YLD>(F, Y + 384, WPTR(WO_WKV), E, F.G, (F.bid + 128) % F.G); }
    { const float* rope = (const float*)(F.ws + WS_ROPE); bf16_t* KR = (bf16_t*)(F.ws + WS_KR);
      for (int t = GTID; t < T; t += GTHREADS) {
        const int pos = t & (SEQ - 1);
#pragma unroll
        for (int i = 0; i < 2; ++i) {
          f32x4 a0, a1, b0, b1; unpack8(*(const u32x4*)(Y + (size_t)t * YLD + YC_KR + 8 * i), a0, a1); unpack8(*(const u32x4*)(Y + (size_t)t * YLD + YC_KR + 16 + 8 * i), b0, b1);
          f32x4 x0, x1, y0, y1;
#pragma unroll
          for (int j = 0; j < 4; ++j) {
            const float c0 = rope[(pos * 16 + 8 * i + j) * 2], s0 = rope[(pos * 16 + 8 * i + j) * 2 + 1], c1 = rope[(pos * 16 + 8 * i + 4 + j) * 2], s1 = rope[(pos * 16 + 8 * i + 4 + j) * 2 + 1];
            x0[j] = a0[j] * c0 - b0[j] * s0; y0[j] = a0[j] * s0 + b0[j] * c0; x1[j] = a1[j] * c1 - b1[j] * s1; y1[j] = a1[j] * s1 + b1[j] * c1; }
          *(u32x4*)(KR + (size_t)t * 32 + 8 * i) = pack8(x0, x1); *(u32x4*)(KR + (size_t)t * 32 + 16 + 8 * i) = pack8(y0, y1);
        }
      } }
    for (int it = F.bid; it < 2048; it += F.G) gla_part1(a, F, it);
  } SYNC(4);
  PH(5) { gla_scan(a, F); } SYNC(5);
  PH(6) {
    for (int c = F.bid; c < 256; c += F.G) {
      const int bh = c & 31, j = c >> 5, b = bh >> 3, h = bh & 7;
      for (int u4 = 0; u4 < 4; ++u4) { const int qb = (u4 == 0) ? 31 - j : (u4 == 1) ? 16 + j : (u4 == 2) ? 15 - j : j; attn_unit(a, F, b, h, qb); }
    }
    __syncthreads();
    for (int it = F.bid; it < 2048; it += F.G) gla_part3(a, F, it);
  } SYNC(6);
  PH(7) { EpiResid<0> E{nullptr, hbA, nullptr, hbA, statp(F, 2), 1.f, nullptr, nullptr}; run_gemm<T, 1024, 1024, 1024>(F, hbB, WPTR(WO_WOUTE), E); } SYNC(7);
}

__device__ __forceinline__ void odd_mixer_phases(const Args& a, const Frame& F, int lo, int hi) {
  bf16_t* const hbA = (bf16_t*)(F.ws + WS_HBA); bf16_t* const hbB = (bf16_t*)(F.ws + WS_HBB);
  bf16_t* const Yo = (bf16_t*)(F.ws + WS_YO); bf16_t* const Upk = (bf16_t*)(F.ws + WS_UPK); bf16_t* const xc = (bf16_t*)(F.ws + WS_XC);
  bf16_t* const yg = (bf16_t*)(F.ws + WS_YG); bf16_t* const la = (bf16_t*)F.out; bf16_t* const bx = (bf16_t*)F.out + (size_t)T * 512;
  PH(13) { EpiWinOdd E{Yo, Upk, statp(F, 5)}; run_gemm<T, 1536, 1024, 1024>(F, hbA, WPTR(WO_WINO), E); } SYNC(13);
  PH(14) {
    { const float* cw = IN_(24); const float* cb = IN_(25);
      for (int it0 = GTID; it0 < T * 64; it0 += 4 * GTHREADS) {
        u32x4 raw[4][4];
#pragma unroll
        for (int q = 0; q < 4; ++q) { const int it = it0 + q * GTHREADS; const int t = it >> 6, c8 = (it & 63) * 8, pos = t & (SEQ - 1);
#pragma unroll
          for (int k = 0; k < 4; ++k) raw[q][k] = (it < T * 64 && pos - 3 + k >= 0) ? *(const u32x4*)(Yo + (size_t)(t - 3 + k) * 1024 + 512 + c8) : (u32x4){0u, 0u, 0u, 0u}; }
#pragma unroll
        for (int q = 0; q < 4; ++q) { const int it = it0 + q * GTHREADS; if (it < T * 64) { const int t = it >> 6, c8 = (it & 63) * 8;
          f32x4 s0 = *(const f32x4*)(cb + c8), s1 = *(const f32x4*)(cb + c8 + 4);
#pragma unroll
          for (int k = 0; k < 4; ++k) { f32x4 v0, v1; unpack8(raw[q][k], v0, v1); s0 += *(const f32x4*)(cw + k * 512 + c8) * v0; s1 += *(const f32x4*)(cw + k * 512 + c8 + 4) * v1; }
          *(u32x4*)(xc + (size_t)t * 512 + c8) = pack8(s0, s1); } }
      } }
    { EpiZ E{(float*)(F.ws + WS_Z)}; run_gemm<1024, 256, 512, 640, 32, (size_t)1024 * 640 * 2, (size_t)256 * 512 * 2>(F, Upk, WPTR(WO_WZ), E); }
  } SYNC(14);
  PH(15) {
    const int nscan = (F.G >= 64) ? 16 : 0;
    if (F.bid < nscan || nscan == 0) {
      const float* AL = (const float*)(F.ws + WS_AL); const float* Z = (const float*)(F.ws + WS_Z);
      const int nthr_s = (nscan ? nscan : F.G) * NTHR;
      for (int gid = GTID; gid < 8192; gid += nthr_s) {
        const int b = gid >> 11, g = (gid >> 6) & 31, p = gid & 63;
        const float ar = AL[(g * 64 + p) * 2], ai_ = AL[(g * 64 + p) * 2 + 1];
        float xr = 0.f, xi = 0.f;
        for (int ch = 0; ch < 256; ch += 16) {
          float zr[16], zi[16];
#pragma unroll
          for (int i = 0; i < 16; ++i) { const size_t zo = ((size_t)(b * 256 + ch + i) * 32 + g) * 128 + p; zr[i] = Z[zo]; zi[i] = Z[zo + 64]; }
#pragma unroll
          for (int i = 0; i < 16; ++i) { bf16_t* up = Upk + ((size_t)g * 1024 + b * 256 + ch + i) * 640 + 512 + p; up[0] = f2bf1(xr); up[64] = f2bf1(xi);
            const float nr = ar * xr - ai_ * xi + zr[i], ni = ar * xi + ai_ * xr + zi[i]; xr = nr; xi = ni; }
        }
      }
    }
    { EpiRG E{la, bx, xc, IN_(27), IN_(29), (const float*)(F.ws + WS_C8SP)};
      if (nscan) run_gemm<T, 1024, 512, 512>(F, xc, WPTR(WO_WRG), E, F.G - nscan, F.bid >= nscan ? F.bid - nscan : -1);
      else run_gemm<T, 1024, 512, 512>(F, xc, WPTR(WO_WRG), E); }
  } SYNC(15);
  PH(16) {
    { float* Aprod = (float*)(F.ws + WS_APROD); float* Hend = (float*)(F.ws + WS_HEND);
      for (int gid = GTID; gid < 512 * 256; gid += GTHREADS) {
        const int chunk = gid >> 8, cp = gid & 255; const size_t base = (size_t)chunk * 64 * 512 + 2 * cp;
        float S0 = 0.f, S1 = 0.f, h0 = 0.f, h1 = 0.f;
        for (int t0 = 0; t0 < 64; t0 += 16) {
          unsigned wl[16], wb[16];
#pragma unroll
          for (int i = 0; i < 16; ++i) { wl[i] = *(const unsigned*)(la + base + (size_t)(t0 + i) * 512); wb[i] = *(const unsigned*)(bx + base + (size_t)(t0 + i) * 512); }
#pragma unroll
          for (int i = 0; i < 16; ++i) { const float l0 = bf_lo(wl[i]), l1 = bf_hi(wl[i]); S0 += l0; S1 += l1; h0 = fexp(l0) * h0 + bf_lo(wb[i]); h1 = fexp(l1) * h1 + bf_hi(wb[i]); }
        }
        Aprod[chunk * 512 + 2 * cp] = fexp(S0); Aprod[chunk * 512 + 2 * cp + 1] = fexp(S1); Hend[chunk * 512 + 2 * cp] = h0; Hend[chunk * 512 + 2 * cp + 1] = h1;
      } }
    { EpiS5Y E{yg, Upk, IN_(38)}; run_gemm<1024, 512, 640, 640, 32, (size_t)1024 * 640 * 2, (size_t)512 * 640 * 2>(F, Upk, WPTR(WO_MW), E); }
  } SYNC(16);
  PH(17) {
    { const float* Aprod = (const float*)(F.ws + WS_APROD); const float* Hend = (const float*)(F.ws + WS_HEND);
      for (int gid = GTID; gid < 512 * 256; gid += GTHREADS) {
        const int chunk = gid >> 8, cp = gid & 255, nb = chunk & 127; const size_t base = (size_t)chunk * 64 * 512 + 2 * cp;
        float h0 = 0.f, h1 = 0.f;
        { int m = chunk - nb;
          for (; m + 8 <= chunk; m += 8) {
            f32x2_t A2[8], H2[8];
#pragma unroll
            for (int i = 0; i < 8; ++i) { A2[i] = *(const f32x2_t*)(Aprod + (m + i) * 512 + 2 * cp); H2[i] = *(const f32x2_t*)(Hend + (m + i) * 512 + 2 * cp); }
#pragma unroll
            for (int i = 0; i < 8; ++i) { h0 = A2[i][0] * h0 + H2[i][0]; h1 = A2[i][1] * h1 + H2[i][1]; }
          }
          for (; m < chunk; ++m) { const f32x2_t A2 = *(const f32x2_t*)(Aprod + m * 512 + 2 * cp), H2 = *(const f32x2_t*)(Hend + m * 512 + 2 * cp); h0 = A2[0] * h0 + H2[0]; h1 = A2[1] * h1 + H2[1]; } }
        for (int t0 = 0; t0 < 64; t0 += 8) {
          unsigned wl[8], wb[8], wg[8], wo[8];
#pragma unroll
          for (int i = 0; i < 8; ++i) { wl[i] = *(const unsigned*)(la + base + (size_t)(t0 + i) * 512); wb[i] = *(const unsigned*)(bx + base + (size_t)(t0 + i) * 512); wg[i] = *(const unsigned*)(Yo + ((size_t)chunk * 64 + t0 + i) * 1024 + 2 * cp); }
#pragma unroll
          for (int i = 0; i < 8; ++i) { h0 = fexp(bf_lo(wl[i])) * h0 + bf_lo(wb[i]); h1 = fexp(bf_hi(wl[i])) * h1 + bf_hi(wb[i]); wo[i] = pk2(h0 * geluf_(bf_lo(wg[i])), h1 * geluf_(bf_hi(wg[i]))); }
#pragma unroll
          for (int i = 0; i < 8; ++i) *(unsigned*)(hbB + ((size_t)chunk * 64 + t0 + i) * 1024 + 2 * cp) = wo[i];
        }
      } }
    { EpiGLU E{hbB, yg, IN_(40)}; run_gemm<T, 512, 512, 512>(F, yg, WPTR(WO_WGLU), E); }
  } SYNC(17);
  PH(18) { EpiResid<0> E{nullptr, hbA, nullptr, hbA, statp(F, 6), 1.f, nullptr, nullptr}; run_gemm<T, 1024, 1024, 1024>(F, hbB, WPTR(WO_WOUTO), E); } SYNC(18);
}

template <int L> __device__ __forceinline__ void layer_phases(const Args& a, const Frame& F, int lo, int hi) {
  constexpr int pb0 = 1 + 10 * L, st0 = 4 * L, pn_ = L ? 19 : 8;
  bf16_t* const hbA = (bf16_t*)(F.ws + WS_HBA); bf16_t* const hbB = (bf16_t*)(F.ws + WS_HBB); bf16_t* const Gb = (bf16_t*)(F.ws + WS_G);
  PH(pb0) { EpiSwiglu E{Gb, statp(F, st0)}; run_gemm<T, 5632, 1024, 1024>(F, hbB, WPTR(WO_W13 + (size_t)(L * 2) * W13_B), E); } SYNC(pb0);
  PH(pb0 + 1) { EpiResid<0> E{nullptr, hbB, nullptr, hbA, statp(F, st0 + 1), 0.5f, nullptr, nullptr}; run_gemm<T, 1024, FF, FF>(F, Gb, WPTR(WO_W2 + (size_t)(L * 2) * W2_B), E); } SYNC(pb0 + 1);
  if (L == 0) even_mixer_phases(a, F, lo, hi); else odd_mixer_phases(a, F, lo, hi);
  PH(pn_) { EpiSwiglu E{Gb, statp(F, st0 + 2)}; run_gemm<T, 5632, 1024, 1024>(F, hbA, WPTR(WO_W13 + (size_t)(L * 2 + 1) * W13_B), E); } SYNC(pn_);
  PH(pn_ + 1) { EpiResid<0> E{nullptr, hbA, nullptr, hbA, statp(F, st0 + 3), 0.5f, nullptr, nullptr}; run_gemm<T, 1024, FF, FF>(F, Gb, WPTR(WO_W2 + (size_t)(L * 2 + 1) * W2_B), E); } SYNC(pn_ + 1);
  PH(pn_ + 2) {
    bf16_t* U = (bf16_t*)(F.ws + WS_U);
    { EpiStore E{U, 1024, nullptr, 0.f}; run_gemm<T, 1024, 256, 256>(F, (const bf16_t*)(F.ws + WS_PB) + (size_t)L * T * 256, WPTR(WO_WUP + (size_t)L * 1024 * 256 * 2), E); }
    { EpiResid<1> E{nullptr, hbA, nullptr, hbB, statp(F, st0 + 4), 0.f, U, statp(F, st0 + 3)}; run_gemm<T, 1024, 1024, 1024>(F, hbA, WPTR(WO_WG + (size_t)L * 1024 * 1024 * 2), E); }
  } SYNC(pn_ + 2);
}

__global__ void __launch_bounds__(NTHR, 2) mega_fwd(Args a) {
  extern __shared__ __attribute__((aligned(16))) uchar lds_raw[];
  Frame F;
  F.lds = (LAS uchar*)lds_raw; F.tid = threadIdx.x; F.lane = F.tid & 63; F.wave = __builtin_amdgcn_readfirstlane(F.tid >> 6);
  F.bid = blockIdx.x; F.G = gridDim.x; F.ws = a.ws; F.out = a.out; F.stat = (sq_t*)(a.ws + WS_STAT);
  const int lo = a.ph_lo, hi = a.ph_hi;
  { volatile LAS unsigned* st = (volatile LAS unsigned*)(F.lds + XB_LDS_OFF);
    if (F.tid < 2) st[F.tid] = 0u;
    __syncthreads();
    F.xb.bar = (unsigned*)(a.ws + WS_XBAR); F.xb.x = 0; F.xb.st = st;
    if (hi - lo > 1) F.xb = xcd_barrier_post((unsigned*)(a.ws + WS_XBAR), st); }
  if (lo < 0) cg::this_grid().sync();
  PH(0) { p0_prologue(a, F); } SYNC(0);
  layer_phases<0>(a, F, lo, hi);
  layer_phases<1>(a, F, lo, hi);
  PH(22) {
    const sq_t* sq = statp(F, 8); const float* gn = IN_(42); const bf16_t* hb = (const bf16_t*)(a.ws + WS_HBB);
    const int gw = F.bid * 8 + F.wave, nw = F.G * 8;
    for (int row = gw; row < T; row += nw) {
      const float rs = rs_of(sq[row], 1.f / 1024.f);
#pragma unroll
      for (int i = 0; i < 2; ++i) { const int c8 = (F.lane + 64 * i) * 8; f32x4 v0, v1; unpack8(*(const u32x4*)(hb + (size_t)row * DM + c8), v0, v1);
        const f32x4 g0 = *(const f32x4*)(gn + c8), g1 = *(const f32x4*)(gn + c8 + 4);
        *(f32x4*)(F.out + (size_t)row * DM + c8) = v0 * rs * g0; *(f32x4*)(F.out + (size_t)row * DM + c8 + 4) = v1 * rs * g1; }
    }
  }
}
#undef PH
#undef SYNC

extern "C" void kernel_launch(void* const* d_in, const int* in_sizes, int n_in, void* d_out, int out_size, void* d_ws, size_t ws_size, hipStream_t stream) {
  static int grid = 0;
  if (grid == 0) {
    if (n_in != 43 || out_size != T * DM || ws_size < WS_END) { fprintf(stderr, "kernel_launch: unexpected shapes (n_in %d out %d ws %zu)\n", n_in, out_size, ws_size); grid = -1; return; }
    int dev = 0, cus = 0, per_cu = 0;
    hipGetDevice(&dev); hipDeviceGetAttribute(&cus, hipDeviceAttributeMultiprocessorCount, dev);
    if (hipFuncSetAttribute((const void*)mega_fwd, hipFuncAttributeMaxDynamicSharedMemorySize, LDS_BYTES) != hipSuccess) { fprintf(stderr, "kernel_launch: hipFuncSetAttribute failed\n"); grid = -1; return; }
    if (hipOccupancyMaxActiveBlocksPerMultiprocessor(&per_cu, (const void*)mega_fwd, NTHR, LDS_BYTES) != hipSuccess || per_cu < 1) { fprintf(stderr, "kernel_launch: occupancy query gave %d\n", per_cu); per_cu = 1; }
    (void)hipGetLastError();
    grid = cus * 1;
    fprintf(stderr, "kernel_launch: grid %d (cus %d, per_cu %d)\n", grid, cus, per_cu);
  }
  if (grid < 0) return;
  hipMemsetAsync((char*)d_ws + WS_STAT, 0, STAT_ZERO_BYTES, stream);
  Args a{};
  for (int i = 0; i < 43; ++i) a.in[i] = (const float*)d_in[i];
  a.out = (float*)d_out; a.ws = (uchar*)d_ws;
#if MK_PER_PHASE_LAUNCH
  for (int ph = 0; ph < NPHASE; ++ph) { a.ph_lo = ph; a.ph_hi = ph + 1;
    for (int rep = 0; rep < 1 + (int)((REPEAT_MASK >> ph) & 1u); ++rep) hipLaunchKernelGGL(mega_fwd, dim3(grid), dim3(NTHR), LDS_BYTES, stream, a); }
#else
  a.ph_lo = 0; a.ph_hi = NPHASE;
  void* args[] = {&a};
  hipError_t e = hipLaunchCooperativeKernel((const void*)mega_fwd, dim3(grid), dim3(NTHR), args, LDS_BYTES, stream);
  if (e != hipSuccess) fprintf(stderr, "cooperative launch failed: %s (grid %d)\n", hipGetErrorString(e), grid);
#endif
}
```

```cpp
#include <hip/hip_runtime.h>
#include <hip/hip_cooperative_groups.h>
#include <cstdio>
#include <cstdint>
namespace cg = cooperative_groups;

#ifndef REPEAT_MASK
#define REPEAT_MASK 0u
#endif
#ifndef MK_PER_PHASE_LAUNCH
#define MK_PER_PHASE_LAUNCH 0
#endif

#define LAS __attribute__((address_space(3)))
typedef unsigned short bf16_t;
typedef unsigned char uchar;
typedef short bf16x8 __attribute__((ext_vector_type(8)));
typedef short s16x4 __attribute__((ext_vector_type(4)));
typedef float f32x4 __attribute__((ext_vector_type(4)));
typedef float f32x16 __attribute__((ext_vector_type(16)));
typedef unsigned u32x4 __attribute__((ext_vector_type(4)));
typedef unsigned u32x2 __attribute__((ext_vector_type(2)));
typedef float f32x2_t __attribute__((ext_vector_type(2)));
typedef __bf16 bf16x2_t __attribute__((ext_vector_type(2)));

constexpr int T = 32768, SEQ = 8192, DM = 1024, FF = 2816;
constexpr float EPS = 1e-6f;
constexpr int NPHASE = 23;
constexpr int NTHR = 512;

constexpr size_t MiB = 1u << 20;
constexpr size_t WS_STAT = 0;
constexpr size_t STAT_ZERO_BYTES = 3 * MiB;
constexpr size_t WS_XBAR = 3 * MiB - 64 * 1024;
constexpr size_t WS_ROPE = 4 * MiB;
constexpr size_t WS_AL = 5 * MiB;
constexpr size_t WS_C8SP = 5 * MiB + 64 * 1024;
constexpr size_t WS_DECAY = 6 * MiB;
constexpr size_t WS_APROD = 7 * MiB;
constexpr size_t WS_HEND = 8 * MiB;
constexpr size_t WS_W = 10 * MiB;
constexpr size_t W13_B = (size_t)5632 * 1024 * 2, W2_B = (size_t)1024 * 2816 * 2;
constexpr size_t WO_W13 = 0;
constexpr size_t WO_W2 = WO_W13 + 4 * W13_B;
constexpr size_t WO_WG = WO_W2 + 4 * W2_B;
constexpr size_t WO_WUP = WO_WG + 2 * (size_t)1024 * 1024 * 2;
constexpr size_t WO_WINE = WO_WUP + 2 * (size_t)1024 * 256 * 2;
constexpr size_t WO_WQ = WO_WINE + (size_t)2304 * 1024 * 2;
constexpr size_t WO_WKV = WO_WQ + (size_t)768 * 384 * 2;
constexpr size_t WO_WOUTE = WO_WKV + (size_t)1024 * 256 * 2;
constexpr size_t WO_WINO = WO_WOUTE + (size_t)1024 * 1024 * 2;
constexpr size_t WO_WRG = WO_WINO + (size_t)1536 * 1024 * 2;
constexpr size_t WO_WGLU = WO_WRG + (size_t)1024 * 512 * 2;
constexpr size_t WO_WOUTO = WO_WGLU + (size_t)512 * 512 * 2;
constexpr size_t WO_MW = WO_WOUTO + (size_t)1024 * 1024 * 2;
constexpr size_t WO_WZ = WO_MW + (size_t)32 * 512 * 640 * 2;
constexpr size_t WO_END = WO_WZ + (size_t)32 * 256 * 512 * 2;
static_assert(WS_W + WO_END <= 124 * MiB, "weights region");
constexpr size_t WS_HBA = 124 * MiB;
constexpr size_t WS_HBB = 188 * MiB;
constexpr size_t WS_PB = 252 * MiB;
constexpr size_t WS_R = 284 * MiB;
constexpr size_t WS_G = WS_R;
constexpr size_t WS_U = WS_R;
constexpr size_t WS_Y = WS_R;
constexpr size_t WS_Q = WS_R + 144 * MiB;
constexpr size_t WS_KR = WS_R + 192 * MiB;
constexpr size_t WS_CKV = WS_R + 194 * MiB;
constexpr size_t WS_YO = WS_R;
constexpr size_t WS_UPK = WS_R + 64 * MiB;
constexpr size_t WS_XC = WS_R + 104 * MiB;
constexpr size_t WS_Z = WS_R + 136 * MiB;
constexpr size_t WS_YG = WS_R + 152 * MiB;
constexpr size_t WS_END = 512 * MiB;
static_assert(WS_CKV + 32 * MiB <= WS_END && WS_YG + 32 * MiB <= WS_END, "ws map");

constexpr int XB_LDS_OFF = 131072 + 2048;
constexpr int LDS_BYTES = 135168;

constexpr int YC_GQ = 640, YC_GK = 896, YC_GV = 1152, YC_GR = 1664, YC_KR = 2176, YC_GLOW = 2208, YLD = 2304;

struct Args { const float* in[43]; float* out; uchar* ws; int ph_lo, ph_hi; };
typedef const __attribute__((address_space(4))) uchar* kaptr_t;
__device__ __forceinline__ kaptr_t ka_base() { kaptr_t p = (kaptr_t)__builtin_amdgcn_kernarg_segment_ptr(); asm volatile("" : "+s"(p)); return p; }
#define IN_(i) (*(const float* const __attribute__((address_space(4)))*)(ka_base() + 8 * (i)))

__device__ __forceinline__ unsigned pk2(float lo, float hi) { f32x2_t v = {lo, hi}; bf16x2_t b = __builtin_convertvector(v, bf16x2_t); return __builtin_bit_cast(unsigned, b); }
__device__ __forceinline__ float bf_lo(unsigned w) { return __uint_as_float(w << 16); }
__device__ __forceinline__ float bf_hi(unsigned w) { return __uint_as_float(w & 0xffff0000u); }
__device__ __forceinline__ float bf1(bf16_t v) { return __uint_as_float(((unsigned)v) << 16); }
__device__ __forceinline__ bf16_t f2bf1(float f) { return (bf16_t)(pk2(f, 0.f) & 0xffffu); }
__device__ __forceinline__ u32x4 pack8(f32x4 a, f32x4 b) { return (u32x4){pk2(a[0], a[1]), pk2(a[2], a[3]), pk2(b[0], b[1]), pk2(b[2], b[3])}; }
__device__ __forceinline__ void unpack8(u32x4 w, f32x4& a, f32x4& b) { a = (f32x4){bf_lo(w[0]), bf_hi(w[0]), bf_lo(w[1]), bf_hi(w[1])}; b = (f32x4){bf_lo(w[2]), bf_hi(w[2]), bf_lo(w[3]), bf_hi(w[3])}; }
__device__ __forceinline__ float fexp(float x) { return __builtin_amdgcn_exp2f(x * 1.4426950408889634f); }
__device__ __forceinline__ float sigmoidf_(float x) { return __builtin_amdgcn_rcpf(1.f + __builtin_amdgcn_exp2f(x * -1.4426950408889634f)); }
__device__ __forceinline__ float one_minus_exp(float x) {
  const float ser = -x * (1.f + x * (0.5f + x * (1.f / 6.f + x * (1.f / 24.f))));
  return x > -0.05f ? ser : 1.f - fexp(x);
}
__device__ __forceinline__ float siluf_(float x) { return x * sigmoidf_(x); }
__device__ __forceinline__ float geluf_(float x) { return x * sigmoidf_(1.5957691216057308f * (x + 0.044715f * x * x * x)); }
typedef unsigned long long sq_t;
__device__ __forceinline__ float rs_of(sq_t sumsq, float inv_n) { return __builtin_amdgcn_rsqf((float)sumsq * (1.f / 16777216.f) * inv_n + EPS); }
__device__ __forceinline__ void sq_add(sq_t* p, float part) { atomicAdd(p, (sq_t)(part * 16777216.f + 0.5f)); }
__device__ __forceinline__ float shx(float v, int m) { return __shfl_xor(v, m, 64); }
__device__ __forceinline__ void sincos_acc(double x, double& s, double& c) {
  const double k = rint(x * 0.63661977236758134308);
  const double r = fma(-k, 1.57079632679489655800, x) - k * 6.12323399573676603587e-17;
  const double r2 = r * r;
  double sp = r * (1.0 + r2 * (-1.0 / 6 + r2 * (1.0 / 120 + r2 * (-1.0 / 5040 + r2 * (1.0 / 362880 + r2 * (-1.0 / 39916800 + r2 * (1.0 / 6227020800.0)))))));
  double cp = 1.0 + r2 * (-0.5 + r2 * (1.0 / 24 + r2 * (-1.0 / 720 + r2 * (1.0 / 40320 + r2 * (-1.0 / 3628800 + r2 * (1.0 / 479001600.0 + r2 * (-1.0 / 87178291200.0)))))));
  const int q = ((int)(long long)k) & 3;
  if (q == 0) { s = sp; c = cp; } else if (q == 1) { s = cp; c = -sp; } else if (q == 2) { s = -sp; c = -cp; } else { s = -cp; c = sp; }
}

namespace pg8 {
constexpr int BM = 256, BK = 64, HALF = 128, HTB = HALF * BK * 2, STAGE_BYTES = 8 * HTB, NXCD = 8, WGM = 8;
__host__ __device__ __forceinline__ int lds_byte(int r, int c) { const int st = (r >> 4) * 2 + (c >> 5), rr = r & 15, cc = c & 31, ob = rr * 64 + cc * 2; return st * 1024 + (ob ^ (((ob >> 9) & 1) << 5)); }
__host__ __device__ __forceinline__ void stage_rc(int b, int& R, int& C) { const int st = b / 1024, sb = b % 1024, swz = sb ^ (((sb >> 9) & 1) << 5); R = (st >> 1) * 16 + swz / 64; C = (st & 1) * 32 + (swz % 64) / 2; }
__host__ __device__ __forceinline__ int perm32(int rho) { const int n = rho >> 4, i = rho & 15; return 8 * (i >> 2) + 4 * n + (i & 3); }

struct Unit { int pm, pn, z; };
struct Gemm { const bf16_t* A; const bf16_t* Bt; };
template <int M_, int N_, int NZ_> struct Order {
  static constexpr int nM = M_ / BM, nN = N_ / BM, per = nM * nN, nz = NZ_, nwg = per * NZ_;
  int G, c;
  __device__ __forceinline__ void init(int G_, int c_) { G = G_; c = c_; }
  __device__ __forceinline__ bool next(int i, Unit& u) const {
    if (c < 0) return false;
    const long L = (long)i * G + c; if (L >= nwg) return false;
    int wgid = (int)L;
    if (nz == 1) {
      { const int q = nwg / NXCD, r = nwg % NXCD, xcd = wgid % NXCD, off = wgid / NXCD; wgid = (xcd < r ? xcd * (q + 1) : r * (q + 1) + (xcd - r) * q) + off; }
      const int nig = WGM * nN, gid = wgid / nig, fm = gid * WGM, gsz = (nM - fm) < WGM ? (nM - fm) : WGM;
      u.pm = fm + ((wgid % nig) % gsz); u.pn = (wgid % nig) / gsz; u.z = 0;
    } else { u.z = wgid / per; const int r = wgid % per; u.pm = r % nM; u.pn = r / nM; }
    return true;
  }
};

template <class Epi, int M_, int N_, int K_, int LDA_, int NZ_, size_t SA_, size_t SB_>
__device__ __forceinline__ void gemm_phase(LAS uchar* lds, const Gemm g, const Order<M_, N_, NZ_>& S, const Epi& E) {
  const int tid = threadIdx.x, wid = __builtin_amdgcn_readfirstlane(tid >> 6), lane = tid & 63, wr = wid >> 2, wc = wid & 3, fr = lane & 15, fq = lane >> 4;
  constexpr int K = K_, nt = K / BK;
  static_assert(M_ % 256 == 0 && N_ % 256 == 0 && K_ % 128 == 0 && K_ >= 256, "gemm shape");
  unsigned voffA[2], voffB[2];
#pragma unroll
  for (int i = 0; i < 2; ++i) { int R, C; stage_rc(tid * 16 + i * 8192, R, C); const int Rb = (R & ~31) + perm32(R & 31);
    voffA[i] = (unsigned)(R * LDA_ + C) * 2u; voffB[i] = (unsigned)(Rb * K + C) * 2u; }
  size_t kstep = (size_t)(BK * 2), hstepA = (size_t)HALF * LDA_ * 2, hstepB = (size_t)HALF * K * 2;
  asm volatile("" : "+s"(kstep), "+s"(hstepA), "+s"(hstepB));
  constexpr size_t tstepA = 2 * (size_t)HALF * LDA_ * 2, tstepB = 2 * (size_t)HALF * K * 2;
  const unsigned ldsw = (unsigned)wid * 1024u;
  const int aoff = lds_byte(wr * 64 + fr, fq * 8), boff = lds_byte(wc * 32 + fr, fq * 8);
#define PG8_SA(b, h) (((b) * 2 + (h)) * HTB)
#define PG8_SB(b, h) ((4 + (b) * 2 + (h)) * HTB)
#define PG8_STAGE(bufoff, gbase, voff) do { _Pragma("unroll") for (int _i = 0; _i < 2; ++_i) \
    __builtin_amdgcn_global_load_lds((const unsigned*)((const char*)(gbase) + (voff)[_i]), (LAS unsigned*)(lds + (bufoff) + ldsw + _i * 8192), 16, 0, 0); } while (0)
#define PG8_LDA(dst, b, h) do { _Pragma("unroll") for (int m = 0; m < 4; ++m) _Pragma("unroll") for (int k = 0; k < 2; ++k) dst[m][k] = *(const LAS bf16x8*)(lds + PG8_SA(b, h) + aoff + m * 2048 + k * 1024); } while (0)
#define PG8_LDB(dst, b, h) do { _Pragma("unroll") for (int n = 0; n < 2; ++n) _Pragma("unroll") for (int k = 0; k < 2; ++k) dst[n][k] = *(const LAS bf16x8*)(lds + PG8_SB(b, h) + boff + n * 2048 + k * 1024); } while (0)
#define PG8_MMA(ai, bj, At, Bt) do { __builtin_amdgcn_s_setprio(1); _Pragma("unroll") for (int m = 0; m < 4; ++m) _Pragma("unroll") for (int n = 0; n < 2; ++n) _Pragma("unroll") for (int k = 0; k < 2; ++k) \
    acc[ai][bj][m][n] = __builtin_amdgcn_mfma_f32_16x16x32_bf16(Bt[n][k], At[m][k], acc[ai][bj][m][n], 0, 0, 0); __builtin_amdgcn_s_setprio(0); } while (0)
#define PG8_WAIT_V(n) asm volatile("s_waitcnt vmcnt(" #n ")" ::: "memory")
#define PG8_WAIT_L(n) asm volatile("s_waitcnt lgkmcnt(" #n ")" ::: "memory")
#define PG8_BAR __builtin_amdgcn_s_barrier()
#define PG8_SCHED __builtin_amdgcn_sched_barrier(0)
  Unit cur, nxt; int ui = 0;
  if (!S.next(0, cur)) return;
  f32x4 acc[2][2][4][2];
#pragma unroll
  for (int a = 0; a < 2; ++a)
#pragma unroll
    for (int b = 0; b < 2; ++b)
#pragma unroll
      for (int m = 0; m < 4; ++m)
#pragma unroll
        for (int n = 0; n < 2; ++n) acc[a][b][m][n] = (f32x4){0.f, 0.f, 0.f, 0.f};
  bf16x8 At[4][2], B0[2][2], B1[2][2];
  const char* cA = (const char*)g.A + (size_t)cur.z * SA_ + (size_t)cur.pm * tstepA;
  const char* cB = (const char*)g.Bt + (size_t)cur.z * SB_ + (size_t)cur.pn * tstepB;
  PG8_WAIT_V(0);
  LAS float* const rsl = (LAS float*)(lds + STAGE_BYTES);
  sq_t pre_v = 0;
  if (Epi::HAS_PRE) { const sq_t* pp = E.pre_ptr(); if (pp && tid < 256) pre_v = pp[cur.pm * 256 + tid]; }
  PG8_STAGE(PG8_SB(0, 0), cB, voffB); PG8_STAGE(PG8_SB(0, 1), cB + hstepB, voffB); PG8_STAGE(PG8_SA(0, 0), cA, voffA); PG8_STAGE(PG8_SA(0, 1), cA + hstepA, voffA);
  if (wr == 1) PG8_BAR;
  PG8_WAIT_V(2); PG8_BAR;
  PG8_STAGE(PG8_SB(1, 0), cB + kstep, voffB); PG8_STAGE(PG8_SA(1, 0), cA + kstep, voffA); PG8_STAGE(PG8_SB(1, 1), cB + hstepB + kstep, voffB);
  PG8_WAIT_V(6); PG8_BAR;
  for (;;) {
    const bool has_next = S.next(ui + 1, nxt);
    const char* nA = has_next ? (const char*)g.A + (size_t)nxt.z * SA_ + (size_t)nxt.pm * tstepA : cA;
    const char* nB = has_next ? (const char*)g.Bt + (size_t)nxt.z * SB_ + (size_t)nxt.pn * tstepB : cB;
#pragma nounroll
    for (int t = 0; t < nt; t += 2) {
      const bool last = (t == nt - 2);
      const char* a1 = cA + (size_t)(t + 1) * kstep;
      const char* a2 = last ? nA : cA + (size_t)(t + 2) * kstep; const char* b2 = last ? nB : cB + (size_t)(t + 2) * kstep;
      const char* a3 = a2 + kstep; const char* b3 = b2 + kstep;
      PG8_LDB(B0, 0, 0); PG8_LDB(B1, 0, 1); PG8_SCHED; PG8_LDA(At, 0, 0); PG8_STAGE(PG8_SA(1, 1), a1 + hstepA, voffA);
      PG8_WAIT_V(8); PG8_WAIT_L(0); PG8_BAR; PG8_MMA(0, 0, At, B0); PG8_MMA(0, 1, At, B1); PG8_BAR; PG8_SCHED;
      PG8_LDA(At, 0, 1); PG8_STAGE(PG8_SB(0, 0), b2, voffB); PG8_STAGE(PG8_SB(0, 1), b2 + hstepB, voffB); PG8_STAGE(PG8_SA(0, 0), a2, voffA);
      PG8_WAIT_V(8); PG8_WAIT_L(0); PG8_BAR; PG8_MMA(1, 0, At, B0); PG8_MMA(1, 1, At, B1); PG8_BAR; PG8_SCHED;
      PG8_LDB(B0, 1, 0); PG8_LDB(B1, 1, 1); PG8_SCHED; PG8_LDA(At, 1, 0); PG8_STAGE(PG8_SA(0, 1), a2 + hstepA, voffA);
      PG8_WAIT_V(8); PG8_WAIT_L(0); PG8_BAR; PG8_MMA(0, 0, At, B0); PG8_MMA(0, 1, At, B1); PG8_BAR; PG8_SCHED;
      PG8_LDA(At, 1, 1); PG8_STAGE(PG8_SB(1, 0), b3, voffB); PG8_STAGE(PG8_SB(1, 1), b3 + hstepB, voffB); PG8_STAGE(PG8_SA(1, 0), a3, voffA);
      PG8_WAIT_V(8); PG8_WAIT_L(0); PG8_BAR; PG8_MMA(1, 0, At, B0); PG8_MMA(1, 1, At, B1); PG8_BAR; PG8_SCHED;
    }
    if (Epi::HAS_PRE) { if (tid < 256) { rsl[tid] = rs_of(pre_v, E.pre_invn()); PG8_WAIT_L(0); } }
    if (wr == 0) PG8_BAR;
    E(acc, cur, wr, wc, fr, fq, rsl);
    if (!has_next) break;
#pragma unroll
    for (int a = 0; a < 2; ++a)
#pragma unroll
      for (int b = 0; b < 2; ++b)
#pragma unroll
        for (int m = 0; m < 4; ++m)
#pragma unroll
          for (int n = 0; n < 2; ++n) acc[a][b][m][n] = (f32x4){0.f, 0.f, 0.f, 0.f};
    cur = nxt; cA = nA; cB = nB; ++ui;
    if (Epi::HAS_PRE) { const sq_t* pp = E.pre_ptr(); if (pp && tid < 256) pre_v = pp[cur.pm * 256 + tid]; }
    if (wr == 1) PG8_BAR;
  }
  PG8_WAIT_V(0);
  PG8_BAR;
#undef PG8_SA
#undef PG8_SB
#undef PG8_STAGE
#undef PG8_LDA
#undef PG8_LDB
#undef PG8_MMA
#undef PG8_WAIT_V
#undef PG8_WAIT_L
#undef PG8_BAR
#undef PG8_SCHED
}
}
using pg8::Unit;
typedef f32x4 AccT[2][2][4][2];

#define EPI_HDR __device__ __forceinline__ void operator()(const AccT& acc, const Unit& u, int wr, int wc, int fr, int fq, const LAS float* rsl) const
#define NO_PRE static constexpr bool HAS_PRE = false; __device__ __forceinline__ const sq_t* pre_ptr() const { return nullptr; } __device__ __forceinline__ float pre_invn() const { return 1.f; }
#define PRE(ptr, invn) static constexpr bool HAS_PRE = true; __device__ __forceinline__ const sq_t* pre_ptr() const { return (ptr); } __device__ __forceinline__ float pre_invn() const { return (invn); }

struct EpiSwiglu {
  bf16_t* G; const sq_t* sq;
  PRE(sq, 1.f / 1024.f)
  EPI_HDR {
#pragma unroll
    for (int ai = 0; ai < 2; ++ai)
#pragma unroll
      for (int m = 0; m < 4; ++m) {
        const int row = u.pm * 256 + ai * 128 + wr * 64 + m * 16 + fr;
        const float rs = rsl[ai * 128 + wr * 64 + m * 16 + fr];
        f32x4 o0, o1;
#pragma unroll
        for (int j = 0; j < 4; ++j) { o0[j] = siluf_(acc[ai][0][m][0][j] * rs) * (acc[ai][1][m][0][j] * rs); o1[j] = siluf_(acc[ai][0][m][1][j] * rs) * (acc[ai][1][m][1][j] * rs); }
        __builtin_nontemporal_store(pack8(o0, o1), (u32x4*)(G + (size_t)row * FF + u.pn * 128 + wc * 32 + 8 * fq));
      }
  }
};

template <int MODE> struct EpiResid {
  const float* res32; const bf16_t* res16; float* out32; bf16_t* hb; sq_t* sq_out; float alpha; const bf16_t* U; const sq_t* sq_in;
  PRE(sq_in, 1.f / 1024.f)
  EPI_HDR {
#pragma unroll
    for (int ai = 0; ai < 2; ++ai)
#pragma unroll
      for (int m = 0; m < 4; ++m) {
        const int row = u.pm * 256 + ai * 128 + wr * 64 + m * 16 + fr;
        float rs = 0.f; if (MODE == 1) rs = rsl[ai * 128 + wr * 64 + m * 16 + fr];
        float part = 0.f;
#pragma unroll
        for (int bj = 0; bj < 2; ++bj) {
          const size_t off = (size_t)row * DM + u.pn * 256 + bj * 128 + wc * 32 + 8 * fq;
          f32x4 r0, r1;
          if (res32) { r0 = *(const f32x4*)(res32 + off); r1 = *(const f32x4*)(res32 + off + 4); }
          else unpack8(*(const u32x4*)(res16 + off), r0, r1);
          f32x4 h0, h1;
          if (MODE == 0) { h0 = r0 + alpha * acc[ai][bj][m][0]; h1 = r1 + alpha * acc[ai][bj][m][1]; }
          else { f32x4 u0, u1; unpack8(*(const u32x4*)(U + off), u0, u1);
#pragma unroll
            for (int j = 0; j < 4; ++j) { h0[j] = r0[j] + u0[j] * sigmoidf_(rs * acc[ai][bj][m][0][j]); h1[j] = r1[j] + u1[j] * sigmoidf_(rs * acc[ai][bj][m][1][j]); } }
          if (out32) { *(f32x4*)(out32 + off) = h0; *(f32x4*)(out32 + off + 4) = h1; }
          if (hb) *(u32x4*)(hb + off) = pack8(h0, h1);
#pragma unroll
          for (int j = 0; j < 4; ++j) part += h0[j] * h0[j] + h1[j] * h1[j];
        }
        part += shx(part, 16); part += shx(part, 32);
        if (fq == 0) sq_add(sq_out + row, part);
      }
  }
};

struct EpiStore {
  bf16_t* O; int ldo; const sq_t* sq; float inv_n;
  PRE(sq, inv_n)
  EPI_HDR {
#pragma unroll
    for (int ai = 0; ai < 2; ++ai)
#pragma unroll
      for (int m = 0; m < 4; ++m) {
        const int row = u.pm * 256 + ai * 128 + wr * 64 + m * 16 + fr;
        const float rs = sq ? rsl[ai * 128 + wr * 64 + m * 16 + fr] : 1.f;
#pragma unroll
        for (int bj = 0; bj < 2; ++bj)
          *(u32x4*)(O + (size_t)row * ldo + u.pn * 256 + bj * 128 + wc * 32 + 8 * fq) = pack8(acc[ai][bj][m][0] * rs, acc[ai][bj][m][1] * rs);
      }
  }
};

struct EpiKV {
  bf16_t* KV; bf16_t* VT; const sq_t* sq;
  PRE(sq, 1.f / 256.f)
  EPI_HDR {
#pragma unroll
    for (int ai = 0; ai < 2; ++ai)
#pragma unroll
      for (int m = 0; m < 4; ++m) {
        const int row = u.pm * 256 + ai * 128 + wr * 64 + m * 16 + fr;
        const float rs = rsl[ai * 128 + wr * 64 + m * 16 + fr];
#pragma unroll
        for (int bj = 0; bj < 2; ++bj) {
          const int col = u.pn * 256 + bj * 128 + wc * 32 + 8 * fq;
          const u32x4 w = pack8(acc[ai][bj][m][0] * rs, acc[ai][bj][m][1] * rs);
          if (wc < 2) *(u32x4*)(KV + (size_t)row * 1024 + col) = w;
          else { bf16_t* vt = VT + ((size_t)((row >> 13) * 8 + (col >> 7)) * 64 + (col & 63)) * SEQ + (row & (SEQ - 1));
#pragma unroll
            for (int e = 0; e < 4; ++e) { vt[(size_t)(2 * e) * SEQ] = (bf16_t)(w[e] & 0xffffu); vt[(size_t)(2 * e + 1) * SEQ] = (bf16_t)(w[e] >> 16); } }
        }
      }
  }
};

struct EpiWinEven {
  bf16_t* Y; const sq_t* sq; sq_t* sq_q; sq_t* sq_kv;
  PRE(sq, 1.f / 1024.f)
  EPI_HDR {
#pragma unroll
    for (int ai = 0; ai < 2; ++ai)
#pragma unroll
      for (int m = 0; m < 4; ++m) {
        const int row = u.pm * 256 + ai * 128 + wr * 64 + m * 16 + fr;
        const float rs = rsl[ai * 128 + wr * 64 + m * 16 + fr];
#pragma unroll
        for (int bj = 0; bj < 2; ++bj) {
          const f32x4 v0 = acc[ai][bj][m][0] * rs, v1 = acc[ai][bj][m][1] * rs;
          *(u32x4*)(Y + (size_t)row * YLD + u.pn * 256 + bj * 128 + wc * 32 + 8 * fq) = pack8(v0, v1);
          const int seg = 2 * u.pn + bj;
          if (seg < 5) {
            float part = 0.f;
#pragma unroll
            for (int j = 0; j < 4; ++j) part += v0[j] * v0[j] + v1[j] * v1[j];
            part += shx(part, 16); part += shx(part, 32);
            if (fq == 0) sq_add((seg < 3 ? sq_q : sq_kv) + row, part);
          }
        }
      }
  }
};

struct EpiQ {
  bf16_t* Q; const sq_t* sq_q; const float* rope;
  PRE(sq_q, 1.f / 384.f)
  EPI_HDR {
    const float QS = 0.10206207261596575f * 1.4426950408889634f;
#pragma unroll
    for (int ai = 0; ai < 2; ++ai)
#pragma unroll
      for (int m = 0; m < 4; ++m) {
        const int row = u.pm * 256 + ai * 128 + wr * 64 + m * 16 + fr;
        const float rs = rsl[ai * 128 + wr * 64 + m * 16 + fr] * QS;
        const int pos = row & (SEQ - 1);
#pragma unroll
        for (int bj = 0; bj < 2; ++bj) {
          const int colg = u.pn * 256 + bj * 128 + wc * 32;
          f32x4 v0 = acc[ai][bj][m][0] * rs, v1 = acc[ai][bj][m][1] * rs;
          if (((colg >> 5) % 3) == 2) {
            const float* cs = rope + ((size_t)pos * 16 + 8 * (fq & 1)) * 2;
            const f32x4 c0 = *(const f32x4*)(cs), c1 = *(const f32x4*)(cs + 4), c2 = *(const f32x4*)(cs + 8), c3 = *(const f32x4*)(cs + 12);
            const float co[8] = {c0[0], c0[2], c1[0], c1[2], c2[0], c2[2], c3[0], c3[2]};
            const float si[8] = {c0[1], c0[3], c1[1], c1[3], c2[1], c2[3], c3[1], c3[3]};
#pragma unroll
            for (int j = 0; j < 4; ++j) {
              const float p0 = shx(v0[j], 32), p1 = shx(v1[j], 32);
              if (fq < 2) { v0[j] = v0[j] * co[j] - p0 * si[j]; v1[j] = v1[j] * co[4 + j] - p1 * si[4 + j]; }
              else { v0[j] = p0 * si[j] + v0[j] * co[j]; v1[j] = p1 * si[4 + j] + v1[j] * co[4 + j]; }
            }
          }
          *(u32x4*)(Q + (size_t)row * 768 + colg + 8 * fq) = pack8(v0, v1);
        }
      }
  }
};

struct EpiWinOdd {
  bf16_t* Yo; bf16_t* Upk; const sq_t* sq;
  PRE(sq, 1.f / 1024.f)
  EPI_HDR {
#pragma unroll
    for (int ai = 0; ai < 2; ++ai)
#pragma unroll
      for (int m = 0; m < 4; ++m) {
        const int row = u.pm * 256 + ai * 128 + wr * 64 + m * 16 + fr;
        const float rs = rsl[ai * 128 + wr * 64 + m * 16 + fr];
#pragma unroll
        for (int bj = 0; bj < 2; ++bj) {
          const int col = u.pn * 256 + bj * 128 + wc * 32 + 8 * fq;
          const u32x4 w = pack8(acc[ai][bj][m][0] * rs, acc[ai][bj][m][1] * rs);
          if (u.pn < 4) *(u32x4*)(Yo + (size_t)row * 1024 + col) = w;
          else { const int cu = col - 1024, g = cu >> 4, ci = cu & 15; *(u32x4*)(Upk + ((size_t)g * 1024 + (row >> 5)) * 640 + (row & 31) * 16 + ci) = w; }
        }
      }
  }
};

struct EpiZ {
  float* Z;
  NO_PRE
  EPI_HDR {
#pragma unroll
    for (int ai = 0; ai < 2; ++ai)
#pragma unroll
      for (int m = 0; m < 4; ++m) {
        const int row = u.pm * 256 + ai * 128 + wr * 64 + m * 16 + fr;
        float* p = Z + ((size_t)row * 32 + u.z) * 128 + wc * 32 + 8 * fq;
        *(f32x4*)p = acc[ai][0][m][0]; *(f32x4*)(p + 4) = acc[ai][0][m][1];
      }
  }
};

struct EpiRG {
  bf16_t* la; bf16_t* bx; const bf16_t* xc; const float* b_a; const float* b_i; const float* c8sp;
  NO_PRE
  EPI_HDR {
    const int c0 = u.pn * 128 + wc * 32 + 8 * fq;
    float ba[8], bi[8], cs[8];
#pragma unroll
    for (int j = 0; j < 8; ++j) { ba[j] = b_a[c0 + j]; bi[j] = b_i[c0 + j]; cs[j] = c8sp[c0 + j]; }
#pragma unroll
    for (int ai = 0; ai < 2; ++ai)
#pragma unroll
      for (int m = 0; m < 4; ++m) {
        const int row = u.pm * 256 + ai * 128 + wr * 64 + m * 16 + fr;
        f32x4 x0, x1; unpack8(*(const u32x4*)(xc + (size_t)row * 512 + c0), x0, x1);
        f32x4 l0, l1, o0, o1;
#pragma unroll
        for (int j = 0; j < 4; ++j) {
          { const float r = sigmoidf_(acc[ai][0][m][0][j] + ba[j]), ig = sigmoidf_(acc[ai][1][m][0][j] + bi[j]);
            const float lg = -cs[j] * r; l0[j] = lg; o0[j] = __builtin_amdgcn_sqrtf(one_minus_exp(2.f * lg)) * (ig * x0[j]); }
          { const float r = sigmoidf_(acc[ai][0][m][1][j] + ba[4 + j]), ig = sigmoidf_(acc[ai][1][m][1][j] + bi[4 + j]);
            const float lg = -cs[4 + j] * r; l1[j] = lg; o1[j] = __builtin_amdgcn_sqrtf(one_minus_exp(2.f * lg)) * (ig * x1[j]); }
        }
        *(u32x4*)(la + (size_t)row * 512 + c0) = pack8(l0, l1);
        *(u32x4*)(bx + (size_t)row * 512 + c0) = pack8(o0, o1);
      }
  }
};

struct EpiS5Y {
  bf16_t* yg; const bf16_t* Upk; const float* dpar;
  NO_PRE
  EPI_HDR {
    const int g = u.z;
#pragma unroll
    for (int ai = 0; ai < 2; ++ai)
#pragma unroll
      for (int m = 0; m < 4; ++m) {
        const int row = u.pm * 256 + ai * 128 + wr * 64 + m * 16 + fr;
#pragma unroll
        for (int bj = 0; bj < 2; ++bj) {
          const int col = u.pn * 256 + bj * 128 + wc * 32 + 8 * fq, t = col >> 4, co = col & 15;
          f32x4 u0, u1; unpack8(*(const u32x4*)(Upk + ((size_t)g * 1024 + row) * 640 + col), u0, u1);
          const f32x4 d0 = *(const f32x4*)(dpar + g * 16 + co), d1 = *(const f32x4*)(dpar + g * 16 + co + 4);
          f32x4 y0, y1;
#pragma unroll
          for (int j = 0; j < 4; ++j) { y0[j] = geluf_(acc[ai][bj][m][0][j] + d0[j] * u0[j]); y1[j] = geluf_(acc[ai][bj][m][1][j] + d1[j] * u1[j]); }
          *(u32x4*)(yg + ((size_t)row * 32 + t) * 512 + g * 16 + co) = pack8(y0, y1);
        }
      }
  }
};

struct EpiGLU {
  bf16_t* mix; const bf16_t* yg; const float* b;
  NO_PRE
  EPI_HDR {
#pragma unroll
    for (int ai = 0; ai < 2; ++ai)
#pragma unroll
      for (int m = 0; m < 4; ++m) {
        const int row = u.pm * 256 + ai * 128 + wr * 64 + m * 16 + fr;
#pragma unroll
        for (int bj = 0; bj < 2; ++bj) {
          const int col = u.pn * 256 + bj * 128 + wc * 32 + 8 * fq;
          f32x4 y0, y1; unpack8(*(const u32x4*)(yg + (size_t)row * 512 + col), y0, y1);
          const f32x4 b0 = *(const f32x4*)(b + col), b1 = *(const f32x4*)(b + col + 4);
          f32x4 o0, o1;
#pragma unroll
          for (int j = 0; j < 4; ++j) { o0[j] = y0[j] * sigmoidf_(acc[ai][bj][m][0][j] + b0[j]); o1[j] = y1[j] * sigmoidf_(acc[ai][bj][m][1][j] + b1[j]); }
          *(u32x4*)(mix + (size_t)row * 1024 + 512 + col) = pack8(o0, o1);
        }
      }
  }
};

#define XB_TMO      128
#define XB_XCNT(j)  (256  + 64 * (j))
#define XB_XSUB(j)  (1280 + 64 * (j))
#define XB_XGEN(j)  (2304 + 64 * (j))
#define XB_TOP      3328
#define XB_TOPGEN   3392
#define XCD_BAR_WORDS 3456
#define XB_SPIN_CAP (1u << 18)

__device__ __forceinline__ unsigned xb_ld(unsigned* p)              { return __hip_atomic_load(p, __ATOMIC_RELAXED, __HIP_MEMORY_SCOPE_AGENT); }
__device__ __forceinline__ unsigned xb_add(unsigned* p, unsigned v) { return __hip_atomic_fetch_add(p, v, __ATOMIC_RELAXED, __HIP_MEMORY_SCOPE_AGENT); }
__device__ __forceinline__ unsigned xb_xcc_id() { return (unsigned)__builtin_amdgcn_s_getreg((3 << 11) | 20) & 0xFu; }
#define XB_SPIN(cond, bar) do { unsigned _sp = 0; while (cond) { __builtin_amdgcn_s_sleep(1); \
    if ((++_sp & 255u) == 0u) { if (xb_ld(&(bar)[XB_TMO])) break; if (_sp > XB_SPIN_CAP) { atomicAdd(&(bar)[XB_TMO], 1u); break; } } } } while (0)

struct XcdBarrier {
    unsigned* bar; unsigned x;
    volatile LAS unsigned* st;
};

__device__ __forceinline__ XcdBarrier xcd_barrier_post(unsigned* bar, volatile LAS unsigned* st) {
    XcdBarrier b; b.bar = bar; b.x = xb_xcc_id(); b.st = st;
    if (threadIdx.x == 0) (void)xb_add(&bar[XB_XCNT(b.x)], 1u);
    return b;
}
__device__ __forceinline__ void xcd_barrier_complete(unsigned* bar, unsigned x, unsigned& nloc, unsigned& nx) {
    const unsigned G = gridDim.x * gridDim.y * gridDim.z;
    unsigned sum, cnt, mine, sp = 0u;
    for (;;) {
        sum = 0u; cnt = 0u; mine = 0u;
#pragma unroll
        for (unsigned j = 0; j < 16; ++j) { const unsigned c = xb_ld(&bar[XB_XCNT(j)]); sum += c; cnt += (c > 0u) ? 1u : 0u; mine = (j == x) ? c : mine; }
        if (sum == G) break;
        __builtin_amdgcn_s_sleep(1);
        if ((++sp & 255u) == 0u) { if (xb_ld(&bar[XB_TMO])) break; if (sp > XB_SPIN_CAP) { atomicAdd(&bar[XB_TMO], 1u); break; } }
    }
    nloc = mine > 0u ? mine : 1u; nx = cnt > 0u ? cnt : 1u;
}

__device__ __forceinline__ void xcd_barrier(const XcdBarrier& b) {
    asm volatile("s_waitcnt vmcnt(0)" ::: "memory");
    __syncthreads();
    if (threadIdx.x == 0) {
        unsigned* bar = b.bar;
        __builtin_amdgcn_s_waitcnt(0);
        unsigned nloc = b.st[0], nx = b.st[1];
        if (nloc == 0u) { xcd_barrier_complete(bar, b.x, nloc, nx); b.st[0] = nloc; b.st[1] = nx; }
        const unsigned old = xb_add(&bar[XB_XSUB(b.x)], 1u);
        const unsigned gen = old / nloc;
        if (old + 1u == (gen + 1u) * nloc) {
            __builtin_amdgcn_fence(__ATOMIC_RELEASE, "agent");
            asm volatile("s_waitcnt vmcnt(0)" ::: "memory");
            const unsigned og = xb_add(&bar[XB_TOP], 1u);
            const unsigned tg = og / nx;
            if (og + 1u == (tg + 1u) * nx) xb_add(&bar[XB_TOPGEN], 1u);
            else XB_SPIN(xb_ld(&bar[XB_TOPGEN]) == tg, bar);
            __builtin_amdgcn_fence(__ATOMIC_ACQUIRE, "agent");
            xb_add(&bar[XB_XGEN(b.x)], 1u);
            asm volatile("s_waitcnt vmcnt(0)" ::: "memory");
        } else {
            XB_SPIN(xb_ld(&bar[XB_XGEN(b.x)]) == gen, bar);
            __builtin_amdgcn_fence(__ATOMIC_ACQUIRE, "agent");
            asm volatile("s_waitcnt vmcnt(0)" ::: "memory");
        }
    }
    __syncthreads();
}

struct Frame {
  LAS uchar* lds; int tid, lane, wave, bid, G;
  sq_t* stat; uchar* ws; float* out; XcdBarrier xb;
};
__device__ __forceinline__ sq_t* statp(const Frame& F, int i) { return F.stat + (size_t)i * T; }
template <int M_, int N_, int K_, int LDA_, int NZ_ = 1, size_t SA_ = 0, size_t SB_ = 0, class Epi>
__device__ __forceinline__ void run_gemm(const Frame& F, const bf16_t* A, const bf16_t* Bt, const Epi& E, int Gsub = -1, int c = -2) {
  pg8::Order<M_, N_, NZ_> S; S.init(Gsub < 0 ? F.G : Gsub, c == -2 ? F.bid : c);
  pg8::Gemm g; g.A = A; g.Bt = Bt;
  pg8::gemm_phase<Epi, M_, N_, K_, LDA_, NZ_, SA_, SB_>(F.lds, g, S, E);
}

struct TJob { const float* src; const float* scale; bf16_t* dst; int K, N, map; };
__device__ __forceinline__ int rowmap(int map, int n) {
  if (map == 0) return n;
  if (map == 1) return 256 * (n >> 7) + (n & 127);
  if (map == 2) return 256 * (n >> 7) + 128 + (n & 127);
  if (n < 640) return n;
  if (n < 672) return YC_KR + (n - 640);
  if (n < 1696) return n - 32;
  if (n < 1712) return YC_GLOW + (n - 1696);
  return YC_GR + (n - 1712);
}
constexpr int NJOB = 23;
__device__ __forceinline__ TJob tjob(const Frame& F, int j) {
  bf16_t* W = (bf16_t*)(F.ws + WS_W);
  TJob t; t.scale = nullptr; t.map = 0;
  if (j < 12) {
    const int q = j / 3, which = j % 3, l = q >> 1, ab = q & 1;
    const float* nrm = IN_(ab ? 7 : 2) + l * 1024;
    if (which == 0) { t.src = IN_(ab ? 8 : 3) + (size_t)l * 1024 * FF; t.scale = nrm; t.dst = (bf16_t*)((uchar*)W + WO_W13 + q * W13_B); t.K = 1024; t.N = FF; t.map = 1; }
    else if (which == 1) { t.src = IN_(ab ? 9 : 4) + (size_t)l * 1024 * FF; t.scale = nrm; t.dst = (bf16_t*)((uchar*)W + WO_W13 + q * W13_B); t.K = 1024; t.N = FF; t.map = 2; }
    else { t.src = IN_(ab ? 10 : 5) + (size_t)l * FF * 1024; t.dst = (bf16_t*)((uchar*)W + WO_W2 + q * W2_B); t.K = FF; t.N = 1024; }
  } else if (j < 16) {
    const int l = (j - 12) >> 1, which = (j - 12) & 1;
    if (which == 0) { t.src = IN_(12) + (size_t)l * 1024 * 1024; t.scale = IN_(11) + l * 1024; t.dst = (bf16_t*)((uchar*)W + WO_WG + (size_t)l * 1024 * 1024 * 2); t.K = 1024; t.N = 1024; }
    else { t.src = IN_(13) + (size_t)l * 256 * 1024; t.dst = (bf16_t*)((uchar*)W + WO_WUP + (size_t)l * 1024 * 256 * 2); t.K = 256; t.N = 1024; }
  } else if (j == 16) { t.src = IN_(14); t.scale = IN_(6); t.dst = (bf16_t*)((uchar*)W + WO_WINE); t.K = 1024; t.N = 2224; t.map = 3; }
  else if (j == 17) { t.src = IN_(16); t.scale = IN_(15); t.dst = (bf16_t*)((uchar*)W + WO_WQ); t.K = 384; t.N = 768; }
  else if (j == 18) { t.src = IN_(18); t.scale = IN_(17); t.dst = (bf16_t*)((uchar*)W + WO_WKV); t.K = 256; t.N = 1024; }
  else if (j == 19) { t.src = IN_(22); t.dst = (bf16_t*)((uchar*)W + WO_WOUTE); t.K = 1024; t.N = 1024; }
  else if (j == 20) { t.src = IN_(23); t.scale = IN_(6) + 1024; t.dst = (bf16_t*)((uchar*)W + WO_WINO); t.K = 1024; t.N = 1536; }
  else if (j == 21) { t.src = IN_(39); t.dst = (bf16_t*)((uchar*)W + WO_WGLU); t.K = 512; t.N = 512; }
  else { t.src = IN_(41); t.dst = (bf16_t*)((uchar*)W + WO_WOUTO); t.K = 1024; t.N = 1024; }
  return t;
}
__device__ __forceinline__ int tjob_tiles(int K, int N) { return (K >> 7) * ((N + 63) >> 6); }

struct TLoad { f32x4 v[4]; float s[4]; };
__device__ __forceinline__ TLoad trans_load(const TJob& j, int tile, int tid) {
  const int ntn = (j.N + 63) >> 6, kt = tile / ntn, nt_ = tile % ntn, k0 = kt * 128, n0 = nt_ * 64;
  TLoad L;
#pragma unroll
  for (int i = 0; i < 4; ++i) {
    const int kk = (tid >> 4) + 32 * i, n4 = (tid & 15) * 4;
    L.v[i] = (f32x4){0.f, 0.f, 0.f, 0.f};
    if (n0 + n4 < j.N) L.v[i] = *(const f32x4*)(j.src + (size_t)(k0 + kk) * j.N + n0 + n4);
    L.s[i] = j.scale ? j.scale[k0 + kk] : 1.f;
  }
  return L;
}
__device__ __forceinline__ void trans_store(const TJob& j, int tile, const TLoad& L, LAS float* sm, int tid) {
  const int ntn = (j.N + 63) >> 6, kt = tile / ntn, nt_ = tile % ntn, k0 = kt * 128, n0 = nt_ * 64;
#pragma unroll
  for (int i = 0; i < 4; ++i) {
    const int kk = (tid >> 4) + 32 * i, n4 = (tid & 15) * 4;
#pragma unroll
    for (int e = 0; e < 4; ++e) sm[kk * 65 + n4 + e] = L.v[i][e] * L.s[i];
  }
  __syncthreads();
  { const int n = tid >> 3, k8 = (tid & 7) * 8;
    if (n0 + n < j.N) {
      bf16_t* drow = j.dst + (size_t)rowmap(j.map, n0 + n) * j.K + k0;
#pragma unroll
      for (int ps = 0; ps < 2; ++ps) {
        f32x4 a, b;
#pragma unroll
        for (int e = 0; e < 4; ++e) { a[e] = sm[(64 * ps + k8 + e) * 65 + n]; b[e] = sm[(64 * ps + k8 + 4 + e) * 65 + n]; }
        *(u32x4*)(drow + 64 * ps + k8) = pack8(a, b);
      }
    } }
  __syncthreads();
}
__host__ __device__ constexpr int job_tiles(int j) {
  return j < 12 ? 352 : (j == 12 || j == 14) ? 128 : (j == 13 || j == 15) ? 32 : j == 16 ? 280 : j == 17 ? 36 : j == 18 ? 32 : j == 19 ? 128 : j == 20 ? 192 : j == 21 ? 32 : 128;
}
__device__ __forceinline__ bool tile_lookup(const Frame& F, int gt, TJob& tj, int& tile) {
  int base = 0, jf = -1;
#pragma unroll
  for (int j = 0; j < NJOB; ++j) { const int n = job_tiles(j); if (jf < 0 && gt < base + n) { jf = j; tile = gt - base; } base += n; }
  if (jf < 0) return false;
  tj = tjob(F, jf);
  return true;
}

__device__ __forceinline__ void s5_group_item(const Args& a, const Frame& F, int g) {
  LAS float* sm = (LAS float*)F.lds;
  LAS float* ApR = sm;
  LAS float* ApI = sm + 2112;
  LAS float* bbR = sm + 4224;
  LAS float* bbI = sm + 5248;
  LAS float* CR = sm + 6272;
  LAS float* CI = sm + 7296;
  LAS float* Kt = sm + 8320;
  const int tid = F.tid;
  const float* a_re = IN_(31); const float* a_im = IN_(32); const float* log_dt = IN_(33);
  const float* b_re = IN_(34); const float* b_im = IN_(35); const float* c_re = IN_(36); const float* c_im = IN_(37);
  if (tid < 64) {
    const int p = tid;
    const double dt = exp((double)log_dt[g]);
    const double lr = a_re[g * 64 + p], li = a_im[g * 64 + p];
    const double mag = exp(lr * dt); double sn, cs; sincos_acc(li * dt, sn, cs);
    const double ar = mag * cs, aim = mag * sn;
    const double den = lr * lr + li * li, nr = ar - 1.0, ni = aim;
    const double cr = (nr * lr + ni * li) / den, ci = (ni * lr - nr * li) / den;
    double pr = 1.0, pi = 0.0;
    for (int t = 0; t <= 32; ++t) { ApR[p * 33 + t] = (float)pr; ApI[p * 33 + t] = (float)pi; const double nr2 = pr * ar - pi * aim, ni2 = pr * aim + pi * ar; pr = nr2; pi = ni2; }
    float* AL = (float*)(F.ws + WS_AL);
    AL[(g * 64 + p) * 2] = ApR[p * 33 + 32]; AL[(g * 64 + p) * 2 + 1] = ApI[p * 33 + 32];
    for (int c = 0; c < 16; ++c) {
      const double br = b_re[(g * 64 + p) * 16 + c], bi = b_im[(g * 64 + p) * 16 + c];
      bbR[p * 16 + c] = (float)(cr * br - ci * bi); bbI[p * 16 + c] = (float)(cr * bi + ci * br);
    }
  }
  for (int i = tid; i < 1024; i += NTHR) { CR[i] = c_re[g * 1024 + i]; CI[i] = c_im[g * 1024 + i]; }
  __syncthreads();
  { const int tau = tid >> 4, co = tid & 15;
    float acc16[16];
#pragma unroll
    for (int ci = 0; ci < 16; ++ci) acc16[ci] = 0.f;
    for (int p = 0; p < 64; ++p) {
      const float cr = CR[co * 64 + p], ci_ = CI[co * 64 + p], ar = ApR[p * 33 + tau], ai = ApI[p * 33 + tau];
      const float xr = cr * ar - ci_ * ai, xi = cr * ai + ci_ * ar;
#pragma unroll
      for (int ci = 0; ci < 16; ++ci) acc16[ci] += xr * bbR[p * 16 + ci] - xi * bbI[p * 16 + ci];
    }
#pragma unroll
    for (int ci = 0; ci < 16; ++ci) Kt[tid * 16 + ci] = acc16[ci];
  }
  __syncthreads();
  bf16_t* MW = (bf16_t*)(F.ws + WS_W + WO_MW) + (size_t)g * 512 * 640;
  for (int it = tid; it < 512 * 80; it += NTHR) {
    const int row = it / 80, cg8 = it % 80, t = row >> 4, co = row & 15;
    float v[8];
    if (cg8 < 64) { const int s = cg8 >> 1, ci0 = (cg8 & 1) * 8;
#pragma unroll
      for (int j = 0; j < 8; ++j) v[j] = (s <= t) ? Kt[(t - s) * 256 + co * 16 + ci0 + j] : 0.f;
    } else {
#pragma unroll
      for (int j = 0; j < 8; ++j) { const int q = (cg8 - 64) * 8 + j, p = q & 63;
        const float xr = CR[co * 64 + p] * ApR[p * 33 + t + 1] - CI[co * 64 + p] * ApI[p * 33 + t + 1];
        const float xi = CR[co * 64 + p] * ApI[p * 33 + t + 1] + CI[co * 64 + p] * ApR[p * 33 + t + 1];
        v[j] = (q < 64) ? xr : -xi; }
    }
    *(u32x4*)(MW + (size_t)row * 640 + cg8 * 8) = (u32x4){pk2(v[0], v[1]), pk2(v[2], v[3]), pk2(v[4], v[5]), pk2(v[6], v[7])};
  }
  bf16_t* WZ = (bf16_t*)(F.ws + WS_W + WO_WZ) + (size_t)g * 256 * 512;
  for (int it = tid; it < 256 * 64; it += NTHR) {
    const int row = it >> 6, cg8 = it & 63, s = cg8 >> 1, ci0 = (cg8 & 1) * 8;
    float v[8];
#pragma unroll
    for (int j = 0; j < 8; ++j) {
      if (row < 128) { const int p = row & 63; const float pr = ApR[p * 33 + 31 - s], pi = ApI[p * 33 + 31 - s], br = bbR[p * 16 + ci0 + j], bi = bbI[p * 16 + ci0 + j];
        v[j] = (row < 64) ? (pr * br - pi * bi) : (pr * bi + pi * br); }
      else v[j] = 0.f;
    }
    *(u32x4*)(WZ + (size_t)row * 512 + cg8 * 8) = (u32x4){pk2(v[0], v[1]), pk2(v[2], v[3]), pk2(v[4], v[5]), pk2(v[6], v[7])};
  }
  __syncthreads();
}

__device__ __forceinline__ void p0_prologue(const Args& a, const Frame& F) {
  const int tid = F.tid, gtid = F.bid * NTHR + tid, gthreads = F.G * NTHR;
  if (F.G < 160) { for (int g = F.bid; g < 32; g += F.G) s5_group_item(a, F, g); }
  { TJob cj, nj; int ct = 0, nt2 = 0; int gt = F.bid;
    bool have = tile_lookup(F, gt, cj, ct);
    TLoad cl; if (have) cl = trans_load(cj, ct, tid);
    while (have) {
      const bool hn = tile_lookup(F, gt + F.G, nj, nt2);
      TLoad nl; if (hn) nl = trans_load(nj, nt2, tid);
      trans_store(cj, ct, cl, (LAS float*)F.lds, tid);
      if (hn) { cj = nj; ct = nt2; cl = nl; }
      have = hn; gt += F.G;
    } }
  { const float* __restrict__ x = IN_(0); bf16_t* __restrict__ hb = (bf16_t*)(F.ws + WS_HBB); sq_t* __restrict__ sq = statp(F, 0);
    const int gw = F.bid * 8 + F.wave, nw = F.G * 8;
    for (int row = gw; row < T; row += 2 * nw) {
      const int row2 = row + nw; const bool two = row2 < T;
      f32x4 v[4], w[4];
#pragma unroll
      for (int i = 0; i < 4; ++i) { v[i] = *(const f32x4*)(x + (size_t)row * DM + (F.lane + 64 * i) * 4); w[i] = two ? *(const f32x4*)(x + (size_t)row2 * DM + (F.lane + 64 * i) * 4) : (f32x4){0.f, 0.f, 0.f, 0.f}; }
      float ss = 0.f, ss2 = 0.f;
#pragma unroll
      for (int i = 0; i < 4; ++i) { ss += v[i][0] * v[i][0] + v[i][1] * v[i][1] + v[i][2] * v[i][2] + v[i][3] * v[i][3]; ss2 += w[i][0] * w[i][0] + w[i][1] * w[i][1] + w[i][2] * w[i][2] + w[i][3] * w[i][3];
        *(u32x2*)(hb + (size_t)row * DM + (F.lane + 64 * i) * 4) = (u32x2){pk2(v[i][0], v[i][1]), pk2(v[i][2], v[i][3])};
        if (two) *(u32x2*)(hb + (size_t)row2 * DM + (F.lane + 64 * i) * 4) = (u32x2){pk2(w[i][0], w[i][1]), pk2(w[i][2], w[i][3])}; }
#pragma unroll
      for (int o = 32; o >= 1; o >>= 1) { ss += shx(ss, o); ss2 += shx(ss2, o); }
      if (F.lane == 0) { sq[row] = (sq_t)(ss * 16777216.f + 0.5f); if (two) sq[row2] = (sq_t)(ss2 * 16777216.f + 0.5f); }
    } }
  { const float* __restrict__ p = IN_(1); bf16_t* __restrict__ pb = (bf16_t*)(F.ws + WS_PB);
#pragma unroll 4
    for (size_t i = gtid; i < (size_t)2 * T * 256 / 8; i += gthreads) {
      const f32x4 v0 = *(const f32x4*)(p + i * 8), v1 = *(const f32x4*)(p + i * 8 + 4);
      *(u32x4*)(pb + i * 8) = pack8(v0, v1); } }
  { float* rope = (float*)(F.ws + WS_ROPE);
    for (int i = gtid; i < SEQ * 16; i += gthreads) {
      const int pos = i >> 4, k = i & 15;
      const float inv = (float)exp(-(double)k / 16.0 * 9.210340371976184);
      const float ang = (float)pos * inv;
      double s, c; sincos_acc((double)ang, s, c);
      rope[i * 2] = (float)c; rope[i * 2 + 1] = (float)s; } }
  { float* c8 = (float*)(F.ws + WS_C8SP); const float* lam = IN_(30);
    for (int i = gtid; i < 512; i += gthreads) c8[i] = (float)(8.0 * log1p(exp(-(double)lam[i]))); }
  { bf16_t* Wrg = (bf16_t*)(F.ws + WS_W + WO_WRG); const float* w_a = IN_(26); const float* w_i = IN_(28);
    for (int it = gtid; it < 1024 * 64; it += gthreads) {
      const int n = it >> 6, k8 = (it & 63) * 8, within = n & 255, bj = within >> 7, c = (n >> 8) * 128 + (within & 127), hb_ = c >> 6, jj = c & 63;
      float v[8];
#pragma unroll
      for (int e = 0; e < 8; ++e) { const int k = k8 + e; v[e] = ((k >> 6) == hb_) ? (bj ? w_i : w_a)[(hb_ * 64 + (k & 63)) * 64 + jj] : 0.f; }
      *(u32x4*)(Wrg + (size_t)n * 512 + k8) = (u32x4){pk2(v[0], v[1]), pk2(v[2], v[3]), pk2(v[4], v[5]), pk2(v[6], v[7])};
    } }
  { bf16_t* W = (bf16_t*)(F.ws + WS_W + WO_WINE);
    for (int it = gtid; it < 80 * 128; it += gthreads) *(u32x4*)(W + (size_t)(2224 + it / 128) * 1024 + (it % 128) * 8) = (u32x4){0u, 0u, 0u, 0u}; }
}

__device__ __forceinline__ f32x4 mma_lds(f32x4 acc, const LAS bf16_t* A, int lda, const LAS bf16_t* Bt, int ldb, int klen, int lane) {
  const int r = lane & 15, q = lane >> 4;
  for (int k0 = 0; k0 < klen; k0 += 32) {
    const bf16x8 a = *(const LAS bf16x8*)(A + r * lda + k0 + 8 * q);
    const bf16x8 b = *(const LAS bf16x8*)(Bt + r * ldb + k0 + 8 * q);
    acc = __builtin_amdgcn_mfma_f32_16x16x32_bf16(a, b, acc, 0, 0, 0);
  }
  return acc;
}

constexpr int GL_GB = 0;
constexpr int GL_GL = 16384;
constexpr int GL_WG = 20480;
constexpr int GL_QE = 24832;
constexpr int GL_KE = 34048;
constexpr int GL_VT = 43264;
constexpr int GL_ST = 61696;
constexpr int GL_ATT = 80128;
constexpr int GL_OF = 89344;
__device__ __forceinline__ float logsig(float z) { return fminf(z, 0.f) - __logf(1.f + fexp(-fabsf(z))); }

__device__ __forceinline__ void gla_gates(const Args& a, const Frame& F, const bf16_t* Y, int tok0, int h) {
  LAS float* gb = (LAS float*)(F.lds + GL_GB); LAS float* gl = (LAS float*)(F.lds + GL_GL); LAS float* wg = (LAS float*)(F.lds + GL_WG);
  const int tid = F.tid;
  const float* wgu = IN_(19); const float* bg = IN_(20);
  { const int c = tid >> 3, r2 = (tid & 7) * 2; const unsigned w = *(const unsigned*)(Y + (size_t)(tok0 + c) * YLD + YC_GLOW + r2); gl[c * 16 + r2] = bf_lo(w); gl[c * 16 + r2 + 1] = bf_hi(w); }
  for (int i = tid; i < 1024; i += NTHR) wg[i] = wgu[(i >> 6) * 256 + h * 64 + (i & 63)];
  if (tid < 64) wg[1024 + tid] = bg[h * 64 + tid];
  __syncthreads();
  { const int c = tid >> 3, d8 = (tid & 7) * 8;
#pragma unroll
    for (int j = 0; j < 8; ++j) { float z = wg[1024 + d8 + j];
#pragma unroll
      for (int r = 0; r < 16; ++r) z += gl[c * 16 + r] * wg[r * 64 + d8 + j];
      gb[c * 64 + d8 + j] = logsig(z) * (1.f / 16.f); } }
  __syncthreads();
  { const int d = tid & 63, seg = tid >> 6; float s = 0.f;
#pragma unroll
    for (int c = 0; c < 8; ++c) { s += gb[(8 * seg + c) * 64 + d]; gb[(8 * seg + c) * 64 + d] = s; }
    __syncthreads();
    float pre = 0.f;
    for (int sg = 0; sg < seg; ++sg) pre += gb[(8 * sg + 7) * 64 + d];
    __syncthreads();
#pragma unroll
    for (int c = 0; c < 8; ++c) gb[(8 * seg + c) * 64 + d] += pre; }
  __syncthreads();
}

__device__ __forceinline__ void gla_part1(const Args& a, const Frame& F, int item) {
  const bf16_t* Y = (const bf16_t*)(F.ws + WS_Y); bf16_t* CKV = (bf16_t*)(F.ws + WS_CKV) + (size_t)item * 8192; float* decay = (float*)(F.ws + WS_DECAY) + item * 64;
  const int b = item >> 9, h = (item >> 7) & 3, n = item & 127, tok0 = b * SEQ + n * 64, tid = F.tid, lane = F.lane, w = F.wave;
  LAS float* gb = (LAS float*)(F.lds + GL_GB); LAS bf16_t* keT = (LAS bf16_t*)(F.lds + GL_KE); LAS bf16_t* vT = (LAS bf16_t*)(F.lds + GL_VT);
  gla_gates(a, F, Y, tok0, h);
  { const int c = tid & 63, d8 = (tid >> 6) * 8; f32x4 k0, k1; unpack8(*(const u32x4*)(Y + (size_t)(tok0 + c) * YLD + YC_GK + h * 64 + d8), k0, k1);
#pragma unroll
    for (int j = 0; j < 8; ++j) { const float kv = (j < 4 ? k0[j] : k1[j - 4]) * fexp(gb[63 * 64 + d8 + j] - gb[c * 64 + d8 + j]); keT[(d8 + j) * 72 + c] = f2bf1(kv); } }
#pragma unroll
  for (int i = 0; i < 2; ++i) { const int c = tid & 63, e8 = ((tid >> 6) + 8 * i) * 8; const u32x4 wv = *(const u32x4*)(Y + (size_t)(tok0 + c) * YLD + YC_GV + h * 128 + e8);
#pragma unroll
    for (int j = 0; j < 4; ++j) { vT[(e8 + 2 * j) * 72 + c] = (bf16_t)(wv[j] & 0xffffu); vT[(e8 + 2 * j + 1) * 72 + c] = (bf16_t)(wv[j] >> 16); } }
  if (tid < 64) decay[tid] = fexp(gb[63 * 64 + tid]);
  { float* GBg = (float*)F.out + (size_t)24 * 1024 * 1024 + (size_t)item * 4096;
    const int c = tid >> 3, d8 = (tid & 7) * 8;
    *(f32x4*)(GBg + c * 64 + d8) = (f32x4){gb[c * 64 + d8], gb[c * 64 + d8 + 1], gb[c * 64 + d8 + 2], gb[c * 64 + d8 + 3]};
    *(f32x4*)(GBg + c * 64 + d8 + 4) = (f32x4){gb[c * 64 + d8 + 4], gb[c * 64 + d8 + 5], gb[c * 64 + d8 + 6], gb[c * 64 + d8 + 7]}; }
  __syncthreads();
#pragma unroll
  for (int nt_ = 0; nt_ < 4; ++nt_) {
    f32x4 acc = {0.f, 0.f, 0.f, 0.f};
    acc = mma_lds(acc, vT + 16 * w * 72, 72, keT + 16 * nt_ * 72, 72, 64, lane);
#pragma unroll
    for (int j = 0; j < 4; ++j) CKV[(16 * w + 4 * (lane >> 4) + j) * 64 + 16 * nt_ + (lane & 15)] = f2bf1(acc[j]);
  }
  __syncthreads();
}

__device__ __forceinline__ void gla_scan(const Args& a, const Frame& F) {
  bf16_t* CKV = (bf16_t*)(F.ws + WS_CKV); const float* decay = (const float*)(F.ws + WS_DECAY);
  for (int gid = F.bid * NTHR + F.tid; gid < 16 * 8192; gid += F.G * NTHR) {
    const int bh = gid >> 13, el = gid & 8191, d = el & 63;
    float st = 0.f;
    for (int n = 0; n < 128; n += 16) {
      float v[16], dc[16];
#pragma unroll
      for (int i = 0; i < 16; ++i) { const int item = bh * 128 + n + i; v[i] = bf1(CKV[(size_t)item * 8192 + el]); dc[i] = decay[item * 64 + d]; }
#pragma unroll
      for (int i = 0; i < 16; ++i) { const int item = bh * 128 + n + i; CKV[(size_t)item * 8192 + el] = f2bf1(st); st = dc[i] * st + v[i]; }
    }
  }
}

__device__ __forceinline__ void gla_part3(const Args& a, const Frame& F, int item) {
  const bf16_t* Y = (const bf16_t*)(F.ws + WS_Y); const bf16_t* CKV = (const bf16_t*)(F.ws + WS_CKV) + (size_t)item * 8192; bf16_t* mix = (bf16_t*)(F.ws + WS_HBB);
  const int b = item >> 9, h = (item >> 7) & 3, n = item & 127, tok0 = b * SEQ + n * 64, tid = F.tid, lane = F.lane, w = F.wave;
  LAS float* gb = (LAS float*)(F.lds + GL_GB); LAS bf16_t* qe = (LAS bf16_t*)(F.lds + GL_QE); LAS bf16_t* ke = (LAS bf16_t*)(F.lds + GL_KE);
  LAS bf16_t* vT = (LAS bf16_t*)(F.lds + GL_VT); LAS bf16_t* stT = (LAS bf16_t*)(F.lds + GL_ST); LAS bf16_t* att = (LAS bf16_t*)(F.lds + GL_ATT); LAS float* of = (LAS float*)(F.lds + GL_OF);
  const u32x4 rraw0 = *(const u32x4*)(Y + (size_t)(tok0 + (tid >> 3)) * YLD + YC_GR + h * 128 + (tid & 7) * 16);
  const u32x4 rraw1 = *(const u32x4*)(Y + (size_t)(tok0 + (tid >> 3)) * YLD + YC_GR + h * 128 + (tid & 7) * 16 + 8);
  { const int c = tid >> 3, d8 = (tid & 7) * 8; f32x4 q0, q1, k0, k1;
    const float* GBg = (const float*)F.out + (size_t)24 * 1024 * 1024 + (size_t)item * 4096 + c * 64 + d8;
    const f32x4 g0 = *(const f32x4*)GBg, g1 = *(const f32x4*)(GBg + 4);
    unpack8(*(const u32x4*)(Y + (size_t)(tok0 + c) * YLD + YC_GQ + h * 64 + d8), q0, q1);
    unpack8(*(const u32x4*)(Y + (size_t)(tok0 + c) * YLD + YC_GK + h * 64 + d8), k0, k1);
#pragma unroll
    for (int j = 0; j < 4; ++j) { const float b0 = g0[j], b1 = g1[j];
      q0[j] *= 0.125f * fexp(b0); q1[j] *= 0.125f * fexp(b1); k0[j] *= fexp(-b0); k1[j] *= fexp(-b1); }
    *(LAS u32x4*)(qe + c * 72 + d8) = pack8(q0, q1); *(LAS u32x4*)(ke + c * 72 + d8) = pack8(k0, k1); }
#pragma unroll
  for (int i = 0; i < 2; ++i) { const int c = tid & 63, e8 = ((tid >> 6) + 8 * i) * 8; const u32x4 wv = *(const u32x4*)(Y + (size_t)(tok0 + c) * YLD + YC_GV + h * 128 + e8);
#pragma unroll
    for (int j = 0; j < 4; ++j) { vT[(e8 + 2 * j) * 72 + c] = (bf16_t)(wv[j] & 0xffffu); vT[(e8 + 2 * j + 1) * 72 + c] = (bf16_t)(wv[j] >> 16); } }
#pragma unroll
  for (int i = 0; i < 2; ++i) { const int q = tid + NTHR * i, e = q >> 3, d8 = (q & 7) * 8; *(LAS u32x4*)(stT + e * 72 + d8) = *(const u32x4*)(CKV + e * 64 + d8); }
  __syncthreads();
#pragma unroll
  for (int i = 0; i < 2; ++i) {
    const int tl = 2 * w + i, mt = tl >> 2, nt_ = tl & 3;
    f32x4 acc = {0.f, 0.f, 0.f, 0.f};
    if (nt_ <= mt) acc = mma_lds(acc, qe + 16 * mt * 72, 72, ke + 16 * nt_ * 72, 72, 64, lane);
#pragma unroll
    for (int j = 0; j < 4; ++j) { const int c = 16 * mt + 4 * (lane >> 4) + j, jj = 16 * nt_ + (lane & 15); att[c * 72 + jj] = f2bf1(jj <= c ? acc[j] : 0.f); }
  }
  __syncthreads();
#pragma unroll
  for (int mt = 0; mt < 4; ++mt) {
    f32x4 acc = {0.f, 0.f, 0.f, 0.f};
    acc = mma_lds(acc, att + 16 * mt * 72, 72, vT + 16 * w * 72, 72, 64, lane);
    acc = mma_lds(acc, qe + 16 * mt * 72, 72, stT + 16 * w * 72, 72, 64, lane);
#pragma unroll
    for (int j = 0; j < 4; ++j) of[(16 * mt + 4 * (lane >> 4) + j) * 132 + 16 * w + (lane & 15)] = acc[j];
  }
  __syncthreads();
  { const int c = tid >> 3, e16 = (tid & 7) * 16; const float* onorm = IN_(21);
    float v[16]; float ss = 0.f;
#pragma unroll
    for (int j = 0; j < 16; ++j) { v[j] = of[c * 132 + e16 + j]; ss += v[j] * v[j]; }
    ss += shx(ss, 1); ss += shx(ss, 2); ss += shx(ss, 4);
    const float rs = __builtin_amdgcn_rsqf(ss * (1.f / 128.f) + EPS);
    f32x4 r0, r1, r2, r3;
    unpack8(rraw0, r0, r1);
    unpack8(rraw1, r2, r3);
    const float rr[16] = {r0[0], r0[1], r0[2], r0[3], r1[0], r1[1], r1[2], r1[3], r2[0], r2[1], r2[2], r2[3], r3[0], r3[1], r3[2], r3[3]};
#pragma unroll
    for (int j = 0; j < 16; ++j) v[j] = v[j] * rs * onorm[e16 + j] * siluf_(rr[j]);
    bf16_t* dst = mix + (size_t)(tok0 + c) * 1024 + 512 + h * 128 + e16;
    *(u32x4*)dst = (u32x4){pk2(v[0], v[1]), pk2(v[2], v[3]), pk2(v[4], v[5]), pk2(v[6], v[7])};
    *(u32x4*)(dst + 8) = (u32x4){pk2(v[8], v[9]), pk2(v[10], v[11]), pk2(v[12], v[13]), pk2(v[14], v[15])};
  }
  __syncthreads();
}

constexpr int AT_K = 0;
constexpr int AT_V = 13312;
constexpr int AT_BUF = 22528;
__device__ __forceinline__ void attn_pv(f32x16& o0, f32x16& o1, const bf16x8 (&pf)[4], const LAS bf16_t* Vs, int r, int hh) {
#pragma unroll
  for (int kb = 0; kb < 2; ++kb)
#pragma unroll
    for (int s2 = 0; s2 < 2; ++s2) {
      const int kofs = 32 * kb + 16 * s2 + 4 * hh;
      const u32x2 a00 = *(const LAS u32x2*)(Vs + r * 68 + kofs), a01 = *(const LAS u32x2*)(Vs + r * 68 + kofs + 8);
      const u32x2 a10 = *(const LAS u32x2*)(Vs + (32 + r) * 68 + kofs), a11 = *(const LAS u32x2*)(Vs + (32 + r) * 68 + kofs + 8);
      const u32x4 A0 = {a00[0], a00[1], a01[0], a01[1]}, A1 = {a10[0], a10[1], a11[0], a11[1]};
      o0 = __builtin_amdgcn_mfma_f32_32x32x16_bf16(__builtin_bit_cast(bf16x8, A0), pf[2 * kb + s2], o0, 0, 0, 0);
      o1 = __builtin_amdgcn_mfma_f32_32x32x16_bf16(__builtin_bit_cast(bf16x8, A1), pf[2 * kb + s2], o1, 0, 0, 0);
    }
}
__device__ __forceinline__ void attn_tile(int kt, const LAS bf16_t* Ks, const LAS bf16_t* Vs, const bf16x8 (&qf)[6], f32x16& o0, f32x16& o1, float& mrun, float& lrun, bf16x8 (&pf)[4], bool& pend,
                                          bool grpB, int qw0, int q, int r, int hh) {
  const int k0 = kt * 64;
  if (k0 > qw0 + 31) return;
  f32x16 s0, s1;
  { const f32x16 z16 = {0.f, 0.f, 0.f, 0.f, 0.f, 0.f, 0.f, 0.f, 0.f, 0.f, 0.f, 0.f, 0.f, 0.f, 0.f, 0.f};
    const bf16x8 ka = *(const LAS bf16x8*)(Ks + r * 104 + 8 * hh);
    const bf16x8 kb = *(const LAS bf16x8*)(Ks + (32 + r) * 104 + 8 * hh);
    s0 = __builtin_amdgcn_mfma_f32_32x32x16_bf16(ka, qf[0], z16, 0, 0, 0);
    s1 = __builtin_amdgcn_mfma_f32_32x32x16_bf16(kb, qf[0], z16, 0, 0, 0); }
#pragma unroll
  for (int ks = 1; ks < 6; ++ks) {
    const bf16x8 ka = *(const LAS bf16x8*)(Ks + r * 104 + 16 * ks + 8 * hh);
    const bf16x8 kb = *(const LAS bf16x8*)(Ks + (32 + r) * 104 + 16 * ks + 8 * hh);
    s0 = __builtin_amdgcn_mfma_f32_32x32x16_bf16(ka, qf[ks], s0, 0, 0, 0);
    s1 = __builtin_amdgcn_mfma_f32_32x32x16_bf16(kb, qf[ks], s1, 0, 0, 0);
  }
  if (k0 + 63 > qw0) {
#pragma unroll
    for (int i = 0; i < 16; ++i) { const int key = k0 + (i & 3) + 8 * (i >> 2) + 4 * hh; if (key > q) s0[i] = -1e30f; if (key + 32 > q) s1[i] = -1e30f; }
  }
  float tm = s0[0];
#pragma unroll
  for (int i = 1; i < 16; ++i) tm = fmaxf(tm, s0[i]);
#pragma unroll
  for (int i = 0; i < 16; ++i) tm = fmaxf(tm, s1[i]);
  tm = fmaxf(tm, shx(tm, 32));
  const float mnew = fmaxf(mrun, tm), alpha = __builtin_amdgcn_exp2f(mrun - mnew);
  const int mnew_changed = (mnew != mrun);
  mrun = mnew;
  f32x2_t ps2 = {0.f, 0.f}; const f32x2_t m2 = {mnew, mnew};
#pragma unroll
  for (int i = 0; i < 8; ++i) {
    f32x2_t a = (f32x2_t){s0[2 * i], s0[2 * i + 1]} - m2, b = (f32x2_t){s1[2 * i], s1[2 * i + 1]} - m2;
    a[0] = __builtin_amdgcn_exp2f(a[0]); a[1] = __builtin_amdgcn_exp2f(a[1]); b[0] = __builtin_amdgcn_exp2f(b[0]); b[1] = __builtin_amdgcn_exp2f(b[1]);
    ps2 += a; ps2 += b;
    s0[2 * i] = a[0]; s0[2 * i + 1] = a[1]; s1[2 * i] = b[0]; s1[2 * i + 1] = b[1];
  }
  lrun = lrun * alpha + (ps2[0] + ps2[1]);
  if (__any(mnew_changed)) {
#pragma unroll
    for (int i = 0; i < 16; ++i) { o0[i] *= alpha; o1[i] *= alpha; }
  }
#pragma unroll
  for (int s2 = 0; s2 < 2; ++s2) {
    const u32x4 w0 = {pk2(s0[8 * s2], s0[8 * s2 + 1]), pk2(s0[8 * s2 + 2], s0[8 * s2 + 3]), pk2(s0[8 * s2 + 4], s0[8 * s2 + 5]), pk2(s0[8 * s2 + 6], s0[8 * s2 + 7])};
    const u32x4 w1 = {pk2(s1[8 * s2], s1[8 * s2 + 1]), pk2(s1[8 * s2 + 2], s1[8 * s2 + 3]), pk2(s1[8 * s2 + 4], s1[8 * s2 + 5]), pk2(s1[8 * s2 + 6], s1[8 * s2 + 7])};
    pf[s2] = __builtin_bit_cast(bf16x8, w0); pf[2 + s2] = __builtin_bit_cast(bf16x8, w1);
  }
  if (grpB) pend = true; else attn_pv(o0, o1, pf, Vs, r, hh);
}

__device__ __forceinline__ void attn_unit(const Args& a, const Frame& F, int b, int h, int qb) {
  const bf16_t* Q = (const bf16_t*)(F.ws + WS_Q); const bf16_t* KV = (const bf16_t*)F.out; const bf16_t* KR = (const bf16_t*)(F.ws + WS_KR); bf16_t* mix = (bf16_t*)(F.ws + WS_HBB);
  const int tid = F.tid, lane = F.lane, w = F.wave, r = lane & 31, hh = lane >> 5;
  const size_t tb = (size_t)b * SEQ;
  const int qw0 = qb * 256 + w * 32, q = qw0 + r;
  bf16x8 qf[6];
#pragma unroll
  for (int ks = 0; ks < 6; ++ks) qf[ks] = *(const bf16x8*)(Q + (tb + q) * 768 + h * 96 + 16 * ks + 8 * hh);
  f32x16 o0, o1;
#pragma unroll
  for (int i = 0; i < 16; ++i) { o0[i] = 0.f; o1[i] = 0.f; }
  float mrun = -1e30f, lrun = 0.f;
  const int nkt = 4 * (qb + 1);
  const bool grpB = (w >= 4); bool pend = false;
  bf16x8 pf[4] = {};
  const int kp0 = tid, kp1 = tid + 512;
  const int kk0 = kp0 / 12, kpt0 = kp0 % 12, kk1 = kp1 / 12, kpt1 = kp1 % 12;
  const int vd = tid >> 3, vpart = tid & 7;
  const bf16_t* gk0 = (kpt0 < 8) ? KV + (tb + kk0) * 1024 + h * 128 + 8 * kpt0 : KR + (tb + kk0) * 32 + 8 * (kpt0 - 8); const size_t gs0 = (kpt0 < 8) ? 64 * 1024 : 64 * 32;
  const bf16_t* gk1 = (kpt1 < 8) ? KV + (tb + kk1) * 1024 + h * 128 + 8 * kpt1 : KR + (tb + kk1) * 32 + 8 * (kpt1 - 8); const size_t gs1 = (kpt1 < 8) ? 64 * 1024 : 64 * 32;
  const bf16_t* gv = KV + (size_t)T * 1024 + ((size_t)(b * 8 + h) * 64 + vd) * SEQ + 8 * vpart;
  u32x4 rk0[2], rk1[2] = {{0u, 0u, 0u, 0u}, {0u, 0u, 0u, 0u}}, rv[2];
#define AT_LOAD(S, kt) do { rk0[S] = *(const u32x4*)(gk0 + (size_t)(kt) * gs0); if (kp1 < 768) rk1[S] = *(const u32x4*)(gk1 + (size_t)(kt) * gs1); rv[S] = *(const u32x4*)(gv + (size_t)(kt) * 64); } while (0)
#define AT_TILE_OFF(t) ((((t) >> 1) & 1) * (2 * AT_BUF) + ((t) & 1) * AT_BUF)
#define AT_WRITE(S, kt) do { const int bo = AT_TILE_OFF(kt); \
    LAS bf16_t* Kw = (LAS bf16_t*)(F.lds + AT_K + bo); LAS bf16_t* Vw = (LAS bf16_t*)(F.lds + AT_V + bo); \
    *(LAS u32x4*)(Kw + kk0 * 104 + 8 * kpt0) = rk0[S]; \
    if (kp1 < 768) *(LAS u32x4*)(Kw + kk1 * 104 + 8 * kpt1) = rk1[S]; \
    *(LAS u32x2*)(Vw + vd * 68 + 8 * vpart) = (u32x2){rv[S][0], rv[S][1]}; *(LAS u32x2*)(Vw + vd * 68 + 8 * vpart + 4) = (u32x2){rv[S][2], rv[S][3]}; } while (0)
#define AT_COMPUTE(kt) do { const int bo = AT_TILE_OFF(kt); \
    if (pend) { attn_pv(o0, o1, pf, (const LAS bf16_t*)(F.lds + AT_V + AT_TILE_OFF((kt) - 1)), r, hh); pend = false; } \
    attn_tile((kt), (const LAS bf16_t*)(F.lds + AT_K + bo), (const LAS bf16_t*)(F.lds + AT_V + bo), qf, o0, o1, mrun, lrun, pf, pend, grpB, qw0, q, r, hh); } while (0)
  AT_LOAD(0, 0); AT_LOAD(1, 1);
  __syncthreads();
  AT_WRITE(0, 0); AT_WRITE(1, 1); AT_LOAD(0, 2); AT_LOAD(1, 3);
  for (int kt = 0; kt < nkt; kt += 2) {
    __syncthreads();
    if (kt + 2 < nkt) { AT_WRITE(0, kt + 2); AT_WRITE(1, kt + 3); if (kt + 4 < nkt) { AT_LOAD(0, kt + 4); AT_LOAD(1, kt + 5); } }
    AT_COMPUTE(kt); AT_COMPUTE(kt + 1);
    if (pend) { attn_pv(o0, o1, pf, (const LAS bf16_t*)(F.lds + AT_V + AT_TILE_OFF(kt + 1)), r, hh); pend = false; }
  }
#undef AT_COMPUTE
#undef AT_TILE_OFF
#undef AT_WRITE
#undef AT_LOAD
  const float lt = lrun + shx(lrun, 32), inv = __builtin_amdgcn_rcpf(lt);
  bf16_t* dst = mix + (tb + q) * 1024 + h * 64;
#pragma unroll
  for (int g4 = 0; g4 < 4; ++g4) {
    const int d = 8 * g4 + 4 * hh;
    *(u32x2*)(dst + d) = (u32x2){pk2(o0[4 * g4] * inv, o0[4 * g4 + 1] * inv), pk2(o0[4 * g4 + 2] * inv, o0[4 * g4 + 3] * inv)};
    *(u32x2*)(dst + 32 + d) = (u32x2){pk2(o1[4 * g4] * inv, o1[4 * g4 + 1] * inv), pk2(o1[4 * g4 + 2] * inv, o1[4 * g4 + 3] * inv)};
  }
}

#define PH(k) if (lo <= (k) && (k) < hi)
#define SYNC(k) do { if (lo <= (k) && (k) + 1 < hi) { xcd_barrier(F.xb); } } while (0)
#define WPTR(off) ((const bf16_t*)(F.ws + WS_W + (off)))
#define GTID (F.bid * NTHR + F.tid)
#define GTHREADS (F.G * NTHR)


__device__ __forceinline__ void even_mixer_phases(const Args& a, const Frame& F, int lo, int hi) {
  bf16_t* const hbA = (bf16_t*)(F.ws + WS_HBA); bf16_t* const hbB = (bf16_t*)(F.ws + WS_HBB);
  bf16_t* const Y = (bf16_t*)(F.ws + WS_Y);
  PH(3) { if (F.G >= 160 && F.bid >= 128 && F.bid < 160) s5_group_item(a, F, F.bid - 128);
    EpiWinEven E{Y, statp(F, 1), statp(F, 9), statp(F, 10)}; run_gemm<T, 2304, 1024, 1024>(F, hbA, WPTR(WO_WINE), E); } SYNC(3);
  PH(4) {
    { EpiQ E{(bf16_t*)(F.ws + WS_Q), statp(F, 9), (const float*)(F.ws + WS_ROPE)}; run_gemm<T, 768, 384, YLD>(F, Y, WPTR(WO_WQ), E); }
    { EpiKV E{(bf16_t*)F.out, (bf16_t*)F.out + (size_t)T * 1024, statp(F, 10)}; run_gemm<T, 1024, 256, YLD>(F, Y + 384, WPTR(WO_WKV), E, F.G, (F.bid + 128) % F.G); }
    { const float* rope = (const float*)(F.ws + WS_ROPE); bf16_t* KR = (bf16_t*)(F.ws + WS_KR);
      for (int t = GTID; t < T; t += GTHREADS) {
        const int pos = t & (SEQ - 1);
#pragma unroll
        for (int i = 0; i < 2; ++i) {
          f32x4 a0, a1, b0, b1; unpack8(*(const u32x4*)(Y + (size_t)t * YLD + YC_KR + 8 * i), a0, a1); unpack8(*(const u32x4*)(Y + (size_t)t * YLD + YC_KR + 16 + 8 * i), b0, b1);
          f32x4 x0, x1, y0, y1;
#pragma unroll
          for (int j = 0; j < 4; ++j) {
            const float c0 = rope[(pos * 16 + 8 * i + j) * 2], s0 = rope[(pos * 16 + 8 * i + j) * 2 + 1], c1 = rope[(pos * 16 + 8 * i + 4 + j) * 2], s1 = rope[(pos * 16 + 8 * i + 4 + j) * 2 + 1];
            x0[j] = a0[j] * c0 - b0[j] * s0; y0[j] = a0[j] * s0 + b0[j] * c0; x1[j] = a1[j] * c1 - b1[j] * s1; y1[j] = a1[j] * s1 + b1[j] * c1; }
          *(u32x4*)(KR + (size_t)t * 32 + 8 * i) = pack8(x0, x1); *(u32x4*)(KR + (size_t)t * 32 + 16 + 8 * i) = pack8(y0, y1);
        }
      } }
    for (int it = F.bid; it < 2048; it += F.G) gla_part1(a, F, it);
  } SYNC(4);
  PH(5) { gla_scan(a, F); } SYNC(5);
  PH(6) {
    for (int c = F.bid; c < 256; c += F.G) {
      const int bh = c & 31, j = c >> 5, b = bh >> 3, h = bh & 7;
      for (int u4 = 0; u4 < 4; ++u4) { const int qb = (u4 == 0) ? 31 - j : (u4 == 1) ? 16 + j : (u4 == 2) ? 15 - j : j; attn_unit(a, F, b, h, qb); }
    }
    __syncthreads();
    for (int it = F.bid; it < 2048; it += F.G) gla_part3(a, F, it);
  } SYNC(6);
  PH(7) { EpiResid<0> E{nullptr, hbA, nullptr, hbA, statp(F, 2), 1.f, nullptr, nullptr}; run_gemm<T, 1024, 1024, 1024>(F, hbB, WPTR(WO_WOUTE), E); } SYNC(7);
}

__device__ __forceinline__ void odd_mixer_phases(const Args& a, const Frame& F, int lo, int hi) {
  bf16_t* const hbA = (bf16_t*)(F.ws + WS_HBA); bf16_t* const hbB = (bf16_t*)(F.ws + WS_HBB);
  bf16_t* const Yo = (bf16_t*)(F.ws + WS_YO); bf16_t* const Upk = (bf16_t*)(F.ws + WS_UPK); bf16_t* const xc = (bf16_t*)(F.ws + WS_XC);
  bf16_t* const yg = (bf16_t*)(F.ws + WS_YG); bf16_t* const la = (bf16_t*)F.out; bf16_t* const bx = (bf16_t*)F.out + (size_t)T * 512;
  PH(13) { EpiWinOdd E{Yo, Upk, statp(F, 5)}; run_gemm<T, 1536, 1024, 1024>(F, hbA, WPTR(WO_WINO), E); } SYNC(13);
  PH(14) {
    { const float* cw = IN_(24); const float* cb = IN_(25);
      for (int it0 = GTID; it0 < T * 64; it0 += 4 * GTHREADS) {
        u32x4 raw[4][4];
#pragma unroll
        for (int q = 0; q < 4; ++q) { const int it = it0 + q * GTHREADS; const int t = it >> 6, c8 = (it & 63) * 8, pos = t & (SEQ - 1);
#pragma unroll
          for (int k = 0; k < 4; ++k) raw[q][k] = (it < T * 64 && pos - 3 + k >= 0) ? *(const u32x4*)(Yo + (size_t)(t - 3 + k) * 1024 + 512 + c8) : (u32x4){0u, 0u, 0u, 0u}; }
#pragma unroll
        for (int q = 0; q < 4; ++q) { const int it = it0 + q * GTHREADS; if (it < T * 64) { const int t = it >> 6, c8 = (it & 63) * 8;
          f32x4 s0 = *(const f32x4*)(cb + c8), s1 = *(const f32x4*)(cb + c8 + 4);
#pragma unroll
          for (int k = 0; k < 4; ++k) { f32x4 v0, v1; unpack8(raw[q][k], v0, v1); s0 += *(const f32x4*)(cw + k * 512 + c8) * v0; s1 += *(const f32x4*)(cw + k * 512 + c8 + 4) * v1; }
          *(u32x4*)(xc + (size_t)t * 512 + c8) = pack8(s0, s1); } }
      } }
    { EpiZ E{(float*)(F.ws + WS_Z)}; run_gemm<1024, 256, 512, 640, 32, (size_t)1024 * 640 * 2, (size_t)256 * 512 * 2>(F, Upk, WPTR(WO_WZ), E); }
  } SYNC(14);
  PH(15) {
    const int nscan = (F.G >= 64) ? 16 : 0;
    if (F.bid < nscan || nscan == 0) {
      const float* AL = (const float*)(F.ws + WS_AL); const float* Z = (const float*)(F.ws + WS_Z);
      const int nthr_s = (nscan ? nscan : F.G) * NTHR;
      for (int gid = GTID; gid < 8192; gid += nthr_s) {
        const int b = gid >> 11, g = (gid >> 6) & 31, p = gid & 63;
        const float ar = AL[(g * 64 + p) * 2], ai_ = AL[(g * 64 + p) * 2 + 1];
        float xr = 0.f, xi = 0.f;
        for (int ch = 0; ch < 256; ch += 16) {
          float zr[16], zi[16];
#pragma unroll
          for (int i = 0; i < 16; ++i) { const size_t zo = ((size_t)(b * 256 + ch + i) * 32 + g) * 128 + p; zr[i] = Z[zo]; zi[i] = Z[zo + 64]; }
#pragma unroll
          for (int i = 0; i < 16; ++i) { bf16_t* up = Upk + ((size_t)g * 1024 + b * 256 + ch + i) * 640 + 512 + p; up[0] = f2bf1(xr); up[64] = f2bf1(xi);
            const float nr = ar * xr - ai_ * xi + zr[i], ni = ar * xi + ai_ * xr + zi[i]; xr = nr; xi = ni; }
        }
      }
    }
    { EpiRG E{la, bx, xc, IN_(27), IN_(29), (const float*)(F.ws + WS_C8SP)};
      if (nscan) run_gemm<T, 1024, 512, 512>(F, xc, WPTR(WO_WRG), E, F.G - nscan, F.bid >= nscan ? F.bid - nscan : -1);
      else run_gemm<T, 1024, 512, 512>(F, xc, WPTR(WO_WRG), E); }
  } SYNC(15);
  PH(16) {
    { float* Aprod = (float*)(F.ws + WS_APROD); float* Hend = (float*)(F.ws + WS_HEND);
      for (int gid = GTID; gid < 512 * 256; gid += GTHREADS) {
        const int chunk = gid >> 8, cp = gid & 255; const size_t base = (size_t)chunk * 64 * 512 + 2 * cp;
        float S0 = 0.f, S1 = 0.f, h0 = 0.f, h1 = 0.f;
        for (int t0 = 0; t0 < 64; t0 += 16) {
          unsigned wl[16], wb[16];
#pragma unroll
          for (int i = 0; i < 16; ++i) { wl[i] = *(const unsigned*)(la + base + (size_t)(t0 + i) * 512); wb[i] = *(const unsigned*)(bx + base + (size_t)(t0 + i) * 512); }
#pragma unroll
          for (int i = 0; i < 16; ++i) { const float l0 = bf_lo(wl[i]), l1 = bf_hi(wl[i]); S0 += l0; S1 += l1; h0 = fexp(l0) * h0 + bf_lo(wb[i]); h1 = fexp(l1) * h1 + bf_hi(wb[i]); }
        }
        Aprod[chunk * 512 + 2 * cp] = fexp(S0); Aprod[chunk * 512 + 2 * cp + 1] = fexp(S1); Hend[chunk * 512 + 2 * cp] = h0; Hend[chunk * 512 + 2 * cp + 1] = h1;
      } }
    { EpiS5Y E{yg, Upk, IN_(38)}; run_gemm<1024, 512, 640, 640, 32, (size_t)1024 * 640 * 2, (size_t)512 * 640 * 2>(F, Upk, WPTR(WO_MW), E); }
  } SYNC(16);
  PH(17) {
    { const float* Aprod = (const float*)(F.ws + WS_APROD); const float* Hend = (const float*)(F.ws + WS_HEND);
      for (int gid = GTID; gid < 512 * 256; gid += GTHREADS) {
        const int chunk = gid >> 8, cp = gid & 255, nb = chunk & 127; const size_t base = (size_t)chunk * 64 * 512 + 2 * cp;
        float h0 = 0.f, h1 = 0.f;
        { int m = chunk - nb;
          for (; m + 8 <= chunk; m += 8) {
            f32x2_t A2[8], H2[8];
#pragma unroll
            for (int i = 0; i < 8; ++i) { A2[i] = *(const f32x2_t*)(Aprod + (m + i) * 512 + 2 * cp); H2[i] = *(const f32x2_t*)(Hend + (m + i) * 512 + 2 * cp); }
#pragma unroll
            for (int i = 0; i < 8; ++i) { h0 = A2[i][0] * h0 + H2[i][0]; h1 = A2[i][1] * h1 + H2[i][1]; }
          }
          for (; m < chunk; ++m) { const f32x2_t A2 = *(const f32x2_t*)(Aprod + m * 512 + 2 * cp), H2 = *(const f32x2_t*)(Hend + m * 512 + 2 * cp); h0 = A2[0] * h0 + H2[0]; h1 = A2[1] * h1 + H2[1]; } }
        for (int t0 = 0; t0 < 64; t0 += 8) {
          unsigned wl[8], wb[8], wg[8], wo[8];
#pragma unroll
          for (int i = 0; i < 8; ++i) { wl[i] = *(const unsigned*)(la + base + (size_t)(t0 + i) * 512); wb[i] = *(const unsigned*)(bx + base + (size_t)(t0 + i) * 512); wg[i] = *(const unsigned*)(Yo + ((size_t)chunk * 64 + t0 + i) * 1024 + 2 * cp); }
#pragma unroll
          for (int i = 0; i < 8; ++i) { h0 = fexp(bf_lo(wl[i])) * h0 + bf_lo(wb[i]); h1 = fexp(bf_hi(wl[i])) * h1 + bf_hi(wb[i]); wo[i] = pk2(h0 * geluf_(bf_lo(wg[i])), h1 * geluf_(bf_hi(wg[i]))); }
#pragma unroll
          for (int i = 0; i < 8; ++i) *(unsigned*)(hbB + ((size_t)chunk * 64 + t0 + i) * 1024 + 2 * cp) = wo[i];
        }
      } }
    { EpiGLU E{hbB, yg, IN_(40)}; run_gemm<T, 512, 512, 512>(F, yg, WPTR(WO_WGLU), E); }
  } SYNC(17);
  PH(18) { EpiResid<0> E{nullptr, hbA, nullptr, hbA, statp(F, 6), 1.f, nullptr, nullptr}; run_gemm<T, 1024, 1024, 1024>(F, hbB, WPTR(WO_WOUTO), E); } SYNC(18);
}

template <int L> __device__ __forceinline__ void layer_phases(const Args& a, const Frame& F, int lo, int hi) {
  constexpr int pb0 = 1 + 10 * L, st0 = 4 * L, pn_ = L ? 19 : 8;
  bf16_t* const hbA = (bf16_t*)(F.ws + WS_HBA); bf16_t* const hbB = (bf16_t*)(F.ws + WS_HBB); bf16_t* const Gb = (bf16_t*)(F.ws + WS_G);
  PH(pb0) { EpiSwiglu E{Gb, statp(F, st0)}; run_gemm<T, 5632, 1024, 1024>(F, hbB, WPTR(WO_W13 + (size_t)(L * 2) * W13_B), E); } SYNC(pb0);
  PH(pb0 + 1) { EpiResid<0> E{nullptr, hbB, nullptr, hbA, statp(F, st0 + 1), 0.5f, nullptr, nullptr}; run_gemm<T, 1024, FF, FF>(F, Gb, WPTR(WO_W2 + (size_t)(L * 2) * W2_B), E); } SYNC(pb0 + 1);
  if (L == 0) even_mixer_phases(a, F, lo, hi); else odd_mixer_phases(a, F, lo, hi);
  PH(pn_) { EpiSwiglu E{Gb, statp(F, st0 + 2)}; run_gemm<T, 5632, 1024, 1024>(F, hbA, WPTR(WO_W13 + (size_t)(L * 2 + 1) * W13_B), E); } SYNC(pn_);
  PH(pn_ + 1) { EpiResid<0> E{nullptr, hbA, nullptr, hbA, statp(F, st0 + 3), 0.5f, nullptr, nullptr}; run_gemm<T, 1024, FF, FF>(F, Gb, WPTR(WO_W2 + (size_t)(L * 2 + 1) * W2_B), E); } SYNC(pn_ + 1);
  PH(pn_ + 2) {
    bf16_t* U = (bf16_t*)(F.ws + WS_U);
    { EpiStore E{U, 1024, nullptr, 0.f}; run_gemm<T, 1024, 256, 256>(F, (const bf16_t*)(F.ws + WS_PB) + (size_t)L * T * 256, WPTR(WO_WUP + (size_t)L * 1024 * 256 * 2), E); }
    { EpiResid<1> E{nullptr, hbA, nullptr, hbB, statp(F, st0 + 4), 0.f, U, statp(F, st0 + 3)}; run_gemm<T, 1024, 1024, 1024>(F, hbA, WPTR(WO_WG + (size_t)L * 1024 * 1024 * 2), E); }
  } SYNC(pn_ + 2);
}

__global__ void __launch_bounds__(NTHR, 2) mega_fwd(Args a) {
  extern __shared__ __attribute__((aligned(16))) uchar lds_raw[];
  Frame F;
  F.lds = (LAS uchar*)lds_raw; F.tid = threadIdx.x; F.lane = F.tid & 63; F.wave = __builtin_amdgcn_readfirstlane(F.tid >> 6);
  F.bid = blockIdx.x; F.G = gridDim.x; F.ws = a.ws; F.out = a.out; F.stat = (sq_t*)(a.ws + WS_STAT);
  const int lo = a.ph_lo, hi = a.ph_hi;
  { volatile LAS unsigned* st = (volatile LAS unsigned*)(F.lds + XB_LDS_OFF);
    if (F.tid < 2) st[F.tid] = 0u;
    __syncthreads();
    F.xb.bar = (unsigned*)(a.ws + WS_XBAR); F.xb.x = 0; F.xb.st = st;
    if (hi - lo > 1) F.xb = xcd_barrier_post((unsigned*)(a.ws + WS_XBAR), st); }
  if (lo < 0) cg::this_grid().sync();
  PH(0) { p0_prologue(a, F); } SYNC(0);
  layer_phases<0>(a, F, lo, hi);
  layer_phases<1>(a, F, lo, hi);
  PH(22) {
    const sq_t* sq = statp(F, 8); const float* gn = IN_(42); const bf16_t* hb = (const bf16_t*)(a.ws + WS_HBB);
    const int gw = F.bid * 8 + F.wave, nw = F.G * 8;
    for (int row = gw; row < T; row += nw) {
      const float rs = rs_of(sq[row], 1.f / 1024.f);
#pragma unroll
      for (int i = 0; i < 2; ++i) { const int c8 = (F.lane + 64 * i) * 8; f32x4 v0, v1; unpack8(*(const u32x4*)(hb + (size_t)row * DM + c8), v0, v1);
        const f32x4 g0 = *(const f32x4*)(gn + c8), g1 = *(const f32x4*)(gn + c8 + 4);
        *(f32x4*)(F.out + (size_t)row * DM + c8) = v0 * rs * g0; *(f32x4*)(F.out + (size_t)row * DM + c8 + 4) = v1 * rs * g1; }
    }
  }
}
#undef PH
#undef SYNC

extern "C" void kernel_launch(void* const* d_in, const int* in_sizes, int n_in, void* d_out, int out_size, void* d_ws, size_t ws_size, hipStream_t stream) {
  static int grid = 0;
  if (grid == 0) {
    if (n_in != 43 || out_size != T * DM || ws_size < WS_END) { fprintf(stderr, "kernel_launch: unexpected shapes (n_in %d out %d ws %zu)\n", n_in, out_size, ws_size); grid = -1; return; }
    int dev = 0, cus = 0, per_cu = 0;
    hipGetDevice(&dev); hipDeviceGetAttribute(&cus, hipDeviceAttributeMultiprocessorCount, dev);
    if (hipFuncSetAttribute((const void*)mega_fwd, hipFuncAttributeMaxDynamicSharedMemorySize, LDS_BYTES) != hipSuccess) { fprintf(stderr, "kernel_launch: hipFuncSetAttribute failed\n"); grid = -1; return; }
    if (hipOccupancyMaxActiveBlocksPerMultiprocessor(&per_cu, (const void*)mega_fwd, NTHR, LDS_BYTES) != hipSuccess || per_cu < 1) { fprintf(stderr, "kernel_launch: occupancy query gave %d\n", per_cu); per_cu = 1; }
    (void)hipGetLastError();
    grid = cus * 1;
    fprintf(stderr, "kernel_launch: grid %d (cus %d, per_cu %d)\n", grid, cus, per_cu);
  }
  if (grid < 0) return;
  hipMemsetAsync((char*)d_ws + WS_STAT, 0, STAT_ZERO_BYTES, stream);
  Args a{};
  for (int i = 0; i < 43; ++i) a.in[i] = (const float*)d_in[i];
  a.out = (float*)d_out; a.ws = (uchar*)d_ws;
#if MK_PER_PHASE_LAUNCH
  for (int ph = 0; ph < NPHASE; ++ph) { a.ph_lo = ph; a.ph_hi = ph + 1;
    for (int rep = 0; rep < 1 + (int)((REPEAT_MASK >> ph) & 1u); ++rep) hipLaunchKernelGGL(mega_fwd, dim3(grid), dim3(NTHR), LDS_BYTES, stream, a); }
#else
  a.ph_lo = 0; a.ph_hi = NPHASE;
  void* args[] = {&a};
  hipError_t e = hipLaunchCooperativeKernel((const void*)mega_fwd, dim3(grid), dim3(NTHR), args, LDS_BYTES, stream);
  if (e != hipSuccess) fprintf(stderr, "cooperative launch failed: %s (grid %d)\n", hipGetErrorString(e), grid);
#endif
}
```
